# Optimizing an MI355X kernel written in HIP

```python
import math
import jax, jax.numpy as jnp
from jax import lax
import numpy as np

D_MODEL = 1024
BATCH = 8
SEQ = 4096
DEPTH = 4

N_MIXERS = 3
N_RET = len(range(0, DEPTH, N_MIXERS))
N_CF = len(range(1, DEPTH, N_MIXERS))
N_SC = len(range(2, DEPTH, N_MIXERS))
RET_HEADS = 4
RET_DK = D_MODEL // RET_HEADS
RET_VDIM = 2 * D_MODEL
RET_DV = RET_VDIM // RET_HEADS
RET_CHUNK = 128
RET_IN = 2 * D_MODEL + 2 * RET_VDIM
ROPE_BASE = 10000.0
CF_KERNEL = 31
SC_KERNEL = 3
D_FF = 4 * D_MODEL
RMS_EPS = 1e-6
LN_EPS = 1e-5

kernel_name = "hybrid_retention_conformer_shortconv_trunk"

F32 = jnp.float32


def rms_norm(x, g):
    xf = x.astype(F32)
    y = xf * lax.rsqrt(jnp.mean(xf * xf, axis=-1, keepdims=True) + RMS_EPS)
    return (y * g.astype(F32)).astype(x.dtype)


def causal_depthwise_conv(x, w):
    k = w.shape[0]
    return lax.conv_general_dilated(
        x, w[:, None, :].astype(x.dtype), window_strides=(1,),
        padding=[(k - 1, 0)], dimension_numbers=("NWC", "WIO", "NWC"),
        feature_group_count=x.shape[-1])


def apply_rotary(t, cos, sin):
    t1, t2 = jnp.split(t, 2, axis=-1)
    return jnp.concatenate([t1 * cos - t2 * sin, t2 * cos + t1 * sin], axis=-1)


def chunkwise_retention(q, k, v):
    bsz, s, h, dk = q.shape
    dv = v.shape[-1]
    nc = s // RET_CHUNK
    log_gamma = jnp.log1p(-jnp.exp2(-5.0 - jnp.arange(h, dtype=F32)))
    idx = jnp.arange(RET_CHUNK, dtype=F32)
    rel = idx[:, None] - idx[None, :]
    intra = jnp.where(rel >= 0, jnp.exp(log_gamma[:, None, None] * jnp.maximum(rel, 0.0)), 0.0)
    q_decay = jnp.exp(log_gamma[:, None] * (idx + 1.0))
    k_decay = jnp.exp(log_gamma[:, None] * (RET_CHUNK - 1.0 - idx))
    chunk_decay = jnp.exp(log_gamma * RET_CHUNK)

    def to_chunks(t):
        return t.reshape(bsz, nc, RET_CHUNK, h, t.shape[-1]).transpose(1, 0, 3, 2, 4)

    def step(state, qkv):
        qc, kc, vc = qkv
        scores = jnp.einsum("bhid,bhjd->bhij", qc, kc) * intra
        out = (jnp.einsum("bhij,bhjv->bhiv", scores, vc)
               + jnp.einsum("bhid,bhdv->bhiv", qc * q_decay[..., None], state))
        state = (state * chunk_decay[:, None, None]
                 + jnp.einsum("bhjd,bhjv->bhdv", kc * k_decay[..., None], vc))
        return state, out

    state0 = jnp.zeros((bsz, h, dk, dv), F32)
    _, ys = lax.scan(step, state0, (to_chunks(q), to_chunks(k), to_chunks(v)))
    return ys.transpose(1, 0, 3, 2, 4).reshape(bsz, s, h, dv)


def retention_mixer(x, positions, w_in, gn_g, w_out):
    bsz, s, _ = x.shape
    proj = x @ w_in
    q, k, v, g = jnp.split(proj, [D_MODEL, 2 * D_MODEL, 2 * D_MODEL + RET_VDIM], axis=-1)
    q = q.reshape(bsz, s, RET_HEADS, RET_DK).astype(F32)
    k = k.reshape(bsz, s, RET_HEADS, RET_DK).astype(F32)
    v = v.reshape(bsz, s, RET_HEADS, RET_DV).astype(F32)
    inv_freq = ROPE_BASE ** (-jnp.arange(0, RET_DK, 2, dtype=F32) / RET_DK)
    ang = positions.astype(F32)[..., None, None] * inv_freq
    cos, sin = jnp.cos(ang), jnp.sin(ang)
    q = apply_rotary(q, cos, sin)
    k = apply_rotary(k, cos, sin) * (RET_DK ** -0.5)
    y = chunkwise_retention(q, k, v)
    mean = jnp.mean(y, axis=-1, keepdims=True)
    var = jnp.mean(jnp.square(y - mean), axis=-1, keepdims=True)
    y = ((y - mean) * lax.rsqrt(var + LN_EPS)).reshape(bsz, s, RET_VDIM) * gn_g.astype(F32)
    y = (jax.nn.silu(g.astype(F32)) * y).astype(x.dtype)
    return y @ w_out


def conformer_conv_mixer(x, w_pw1, b_pw1, w_dw, b_dw, ln_g, ln_b, w_pw2, b_pw2):
    h = x @ w_pw1 + b_pw1
    a, gate = jnp.split(h, 2, axis=-1)
    h = a * jax.nn.sigmoid(gate)
    h = causal_depthwise_conv(h, w_dw) + b_dw
    hf = h.astype(F32)
    mean = jnp.mean(hf, axis=-1, keepdims=True)
    var = jnp.mean(jnp.square(hf - mean), axis=-1, keepdims=True)
    hf = (hf - mean) * lax.rsqrt(var + LN_EPS) * ln_g.astype(F32) + ln_b.astype(F32)
    h = jax.nn.silu(hf).astype(x.dtype)
    return h @ w_pw2 + b_pw2


def short_conv_mixer(x, w_in, w_conv, w_out):
    gb, gc, h = jnp.split(x @ w_in, 3, axis=-1)
    u = causal_depthwise_conv(gc * h, w_conv)
    return (gb * u) @ w_out


def squared_relu_mlp(x, w1, w2):
    return jnp.square(jax.nn.relu(x @ w1)) @ w2


def setup_inputs(seed: int = 0) -> dict:
    key = jax.random.key(seed)
    ks = iter(jax.random.split(key, 32))

    def dense(shape, fan_in):
        return jax.random.normal(next(ks), shape, F32) * (fan_in ** -0.5)

    def small(shape, scale):
        return jax.random.normal(next(ks), shape, F32) * scale

    x = jax.random.normal(next(ks), (BATCH, SEQ, D_MODEL), F32)
    positions = jnp.broadcast_to(jnp.arange(SEQ, dtype=jnp.int32), (BATCH, SEQ))
    return {
        "x": x,
        "positions": positions,
        "norm_g": 1.0 + small((DEPTH, 4, D_MODEL), 0.05),
        "ret_w_in": dense((N_RET, D_MODEL, RET_IN), D_MODEL),
        "ret_gn_g": 1.0 + small((N_RET, RET_VDIM), 0.05),
        "ret_w_out": dense((N_RET, RET_VDIM, D_MODEL), RET_VDIM),
        "cf_w_pw1": dense((N_CF, D_MODEL, 2 * D_MODEL), D_MODEL),
        "cf_b_pw1": small((N_CF, 2 * D_MODEL), 0.01),
        "cf_w_dw": dense((N_CF, CF_KERNEL, D_MODEL), CF_KERNEL),
        "cf_b_dw": small((N_CF, D_MODEL), 0.01),
        "cf_ln_g": 1.0 + small((N_CF, D_MODEL), 0.05),
        "cf_ln_b": small((N_CF, D_MODEL), 0.01),
        "cf_w_pw2": dense((N_CF, D_MODEL, D_MODEL), D_MODEL),
        "cf_b_pw2": small((N_CF, D_MODEL), 0.01),
        "sc_w_in": dense((N_SC, D_MODEL, 3 * D_MODEL), D_MODEL),
        "sc_w_conv": dense((N_SC, SC_KERNEL, D_MODEL), SC_KERNEL),
        "sc_w_out": dense((N_SC, D_MODEL, D_MODEL), D_MODEL),
        "mlp_w1": dense((DEPTH, D_MODEL, D_FF), D_MODEL),
        "mlp_w2": dense((DEPTH, D_FF, D_MODEL), D_FF),
    }


def reference(x, positions, norm_g, ret_w_in, ret_gn_g, ret_w_out,
              cf_w_pw1, cf_b_pw1, cf_w_dw, cf_b_dw, cf_ln_g, cf_ln_b, cf_w_pw2, cf_b_pw2,
              sc_w_in, sc_w_conv, sc_w_out, mlp_w1, mlp_w2):
    for i in range(DEPTH):
        kind, j = i % N_MIXERS, i // N_MIXERS
        h = rms_norm(x, norm_g[i, 0])
        if kind == 0:
            h = retention_mixer(h, positions, ret_w_in[j], ret_gn_g[j], ret_w_out[j])
        elif kind == 1:
            h = conformer_conv_mixer(h, cf_w_pw1[j], cf_b_pw1[j], cf_w_dw[j], cf_b_dw[j],
                                     cf_ln_g[j], cf_ln_b[j], cf_w_pw2[j], cf_b_pw2[j])
        else:
            h = short_conv_mixer(h, sc_w_in[j], sc_w_conv[j], sc_w_out[j])
        x = x + rms_norm(h, norm_g[i, 1])
        h = squared_relu_mlp(rms_norm(x, norm_g[i, 2]), mlp_w1[i], mlp_w2[i])
        x = x + rms_norm(h, norm_g[i, 3])
    return x
```

```cpp
#include <hip/hip_runtime.h>
#include <cstdio>
#include <cstdint>

#ifndef PROBE_BAR2
#define PROBE_BAR2 0
#endif
#ifndef PROBE_DUP
#define PROBE_DUP 0
#endif
#ifndef MK_PER_PHASE
#define MK_PER_PHASE 0
#endif

namespace pg8 {
#define PG8_LAS __attribute__((address_space(3)))
typedef unsigned short bf16_t;
typedef short bf16x8 __attribute__((ext_vector_type(8)));
typedef float f32x4 __attribute__((ext_vector_type(4)));
typedef float f32x2 __attribute__((ext_vector_type(2)));
typedef unsigned u32x4 __attribute__((ext_vector_type(4)));
typedef unsigned u32x2 __attribute__((ext_vector_type(2)));
constexpr int BM = 256, BK = 64, HALF = 128, HTB = HALF * BK * 2, STAGE_BYTES = 8 * HTB, NXCD = 8, WGM = 8;

__host__ __device__ __forceinline__ int lds_byte(int r, int c) { const int st = (r >> 4) * 2 + (c >> 5), rr = r & 15, cc = c & 31, ob = rr * 64 + cc * 2; return st * 1024 + (ob ^ (((ob >> 9) & 1) << 5)); }
__host__ __device__ __forceinline__ void stage_rc(int b, int& R, int& C) { const int st = b / 1024, sb = b % 1024, swz = sb ^ (((sb >> 9) & 1) << 5); R = (st >> 1) * 16 + swz / 64; C = (st & 1) * 32 + (swz % 64) / 2; }
__host__ __device__ __forceinline__ int perm32(int rho) { const int n = rho >> 4, i = rho & 15; return 8 * (i >> 2) + 4 * n + (i & 3); }

struct Unit { int pm, pn; };

struct Ord {
    int nM, nN, nwg, G, c;
    __device__ __forceinline__ void init(int nM_, int nN_, int G_, int c_) { nM = nM_; nN = nN_; nwg = nM * nN; G = G_; c = c_; }
    __device__ __forceinline__ bool next(int i, Unit& u) const {
        const long L = (long)i * G + c; if (L >= nwg) return false;
        int wgid = (int)L; { const int q = nwg / NXCD, r = nwg % NXCD, xcd = wgid % NXCD, off = wgid / NXCD; wgid = (xcd < r ? xcd * (q + 1) : r * (q + 1) + (xcd - r) * q) + off; }
        const int nig = WGM * nN, gid = wgid / nig, fm = gid * WGM, gsz = (nM - fm) < WGM ? (nM - fm) : WGM;
        u.pm = fm + ((wgid % nig) % gsz); u.pn = (wgid % nig) / gsz; return true;
    }
    __device__ __forceinline__ void a_ready(const Unit&) const {}
    __device__ __forceinline__ void done(const Unit&) const {}
};

__device__ __forceinline__ unsigned cvt_pk_bf16(float lo, float hi) { unsigned r; asm volatile("v_cvt_pk_bf16_f32 %0, %1, %2" : "=v"(r) : "v"(lo), "v"(hi)); return r; }
__device__ __forceinline__ u32x4 pack8(const f32x4 v0, const f32x4 v1) { u32x4 w; w.x = cvt_pk_bf16(v0[0], v0[1]); w.y = cvt_pk_bf16(v0[2], v0[3]); w.z = cvt_pk_bf16(v1[0], v1[1]); w.w = cvt_pk_bf16(v1[2], v1[3]); return w; }
__device__ __forceinline__ float bf_lo(unsigned w) { return __uint_as_float(w << 16); }
__device__ __forceinline__ float bf_hi(unsigned w) { return __uint_as_float(w & 0xffff0000u); }
__device__ __forceinline__ float fast_sigmoid(float x) { return __builtin_amdgcn_rcpf(1.0f + __builtin_amdgcn_exp2f(-1.44269504f * x)); }

template <class Epi, class Sched, bool ALIGN_EPI, bool SP2>
__device__ __forceinline__ void gemm_phase(PG8_LAS unsigned char* lds, const int lda, const int ldb, const int K, const Sched& S, const Epi& E) {
    int tid_o = threadIdx.x; asm volatile("" : "+v"(tid_o));
    const int tid = tid_o, wid = __builtin_amdgcn_readfirstlane(tid >> 6), lane = tid & 63, wr = wid >> 2, wc = wid & 3, fr = lane & 15, fq = lane >> 4;
    int nt = K / BK; asm volatile("" : "+s"(nt));
    unsigned voffA[2], voffB[2];
#pragma unroll
    for (int i = 0; i < 2; ++i) { int R, C; stage_rc(tid * 16 + i * 8192, R, C); const int Rb = Epi::PERM ? ((R & ~31) + perm32(R & 31)) : R;
        voffA[i] = (unsigned)(R * lda + C) * 2u; voffB[i] = (unsigned)(Rb * ldb + C) * 2u; }
    const size_t kstep = (size_t)(BK * 2);
    const size_t hA = (size_t)HALF * lda * 2, hB = (size_t)HALF * ldb * 2;
    const unsigned ldsw = (unsigned)wid * 1024u;
    const int aoff = lds_byte(wr * 64 + fr, fq * 8), boff = lds_byte(wc * 32 + fr, fq * 8);
#define PG8_SA(b, h) (((b) * 2 + (h)) * HTB)
#define PG8_SB(b, h) ((4 + (b) * 2 + (h)) * HTB)
#define PG8_STAGE(bufoff, gbase, voff) do { _Pragma("unroll") for (int _i = 0; _i < 2; ++_i) \
        __builtin_amdgcn_global_load_lds((const unsigned*)((const char*)(gbase) + (voff)[_i]), (PG8_LAS unsigned*)(lds + (bufoff) + ldsw + _i * 8192), 16, 0, 0); } while (0)
#define PG8_LDA(dst, b, h) do { _Pragma("unroll") for (int m = 0; m < 4; ++m) _Pragma("unroll") for (int k = 0; k < 2; ++k) dst[m][k] = *(const PG8_LAS bf16x8*)(lds + PG8_SA(b, h) + aoff + m * 2048 + k * 1024); } while (0)
#define PG8_LDB(dst, b, h) do { _Pragma("unroll") for (int n = 0; n < 2; ++n) _Pragma("unroll") for (int k = 0; k < 2; ++k) dst[n][k] = *(const PG8_LAS bf16x8*)(lds + PG8_SB(b, h) + boff + n * 2048 + k * 1024); } while (0)
#define PG8_MMA(ai, bj, At, Bt) do { __builtin_amdgcn_s_setprio(1); _Pragma("unroll") for (int m = 0; m < 4; ++m) _Pragma("unroll") for (int n = 0; n < 2; ++n) _Pragma("unroll") for (int k = 0; k < 2; ++k) \
        acc[ai][bj][m][n] = __builtin_amdgcn_mfma_f32_16x16x32_bf16(Bt[n][k], At[m][k], acc[ai][bj][m][n], 0, 0, 0); __builtin_amdgcn_s_setprio(0); } while (0)
#define PG8_WAIT_V(n) asm volatile("s_waitcnt vmcnt(" #n ")" ::: "memory")
#define PG8_WAIT_L(n) asm volatile("s_waitcnt lgkmcnt(" #n ")" ::: "memory")
#define PG8_BAR __builtin_amdgcn_s_barrier()
#define PG8_SCHED __builtin_amdgcn_sched_barrier(0)
    Unit cur, nxt; int ui = 0;
    if (!S.next(0, cur)) return;
    f32x4 acc[2][2][4][2];
#pragma unroll
    for (int a = 0; a < 2; ++a)
#pragma unroll
        for (int b = 0; b < 2; ++b)
#pragma unroll
            for (int m = 0; m < 4; ++m)
#pragma unroll
                for (int n = 0; n < 2; ++n) acc[a][b][m][n] = (f32x4){0.f, 0.f, 0.f, 0.f};
    bf16x8 At[4][2], B0[2][2], B1[2][2];
    const char* cA = S.a_ptr(cur); const char* cB = S.b_ptr(cur);
    S.a_ready(cur);
    if constexpr (SP2) {
        PG8_STAGE(PG8_SB(0, 0), cB, voffB); PG8_STAGE(PG8_SB(0, 1), cB + hB, voffB); PG8_STAGE(PG8_SA(0, 0), cA, voffA); PG8_STAGE(PG8_SA(0, 1), cA + hA, voffA);
        if (wr == 1) PG8_BAR;
        PG8_WAIT_V(2); PG8_BAR;
        PG8_STAGE(PG8_SB(1, 0), cB + kstep, voffB); PG8_STAGE(PG8_SA(1, 0), cA + kstep, voffA); PG8_STAGE(PG8_SB(1, 1), cB + hB + kstep, voffB);
        PG8_WAIT_V(6); PG8_BAR;
    } else {
        PG8_STAGE(PG8_SB(0, 0), cB, voffB); PG8_STAGE(PG8_SA(0, 0), cA, voffA); PG8_STAGE(PG8_SB(0, 1), cB + hB, voffB); PG8_STAGE(PG8_SA(0, 1), cA + hA, voffA);
        if (wr == 1) PG8_BAR;
        PG8_WAIT_V(4); PG8_BAR;
        PG8_STAGE(PG8_SB(1, 0), cB + kstep, voffB); PG8_STAGE(PG8_SA(1, 0), cA + kstep, voffA); PG8_STAGE(PG8_SB(1, 1), cB + hB + kstep, voffB);
        PG8_WAIT_V(6); PG8_BAR;
    }
    for (;;) {
        const bool has_next = S.next(ui + 1, nxt);
        const char* nA = has_next ? S.a_ptr(nxt) : cA; const char* nB = has_next ? S.b_ptr(nxt) : cB;
        for (int t = 0; t < nt; t += 2) {
            const bool last = (t == nt - 2);
            const char* a1 = cA + (size_t)(t + 1) * kstep;
            const char* a2 = last ? nA : cA + (size_t)(t + 2) * kstep; const char* b2 = last ? nB : cB + (size_t)(t + 2) * kstep;
            const char* a3 = a2 + kstep; const char* b3 = b2 + kstep;
            if (last && has_next) S.a_ready(nxt);
            if constexpr (SP2) {
            PG8_LDB(B0, 0, 0); PG8_LDB(B1, 0, 1); PG8_SCHED; PG8_LDA(At, 0, 0); PG8_STAGE(PG8_SA(1, 1), a1 + hA, voffA);
            PG8_WAIT_V(8); PG8_WAIT_L(0); PG8_BAR; PG8_MMA(0, 0, At, B0); PG8_MMA(0, 1, At, B1); PG8_BAR; PG8_SCHED;
            PG8_LDA(At, 0, 1); PG8_STAGE(PG8_SB(0, 0), b2, voffB); PG8_STAGE(PG8_SB(0, 1), b2 + hB, voffB); PG8_STAGE(PG8_SA(0, 0), a2, voffA);
            PG8_WAIT_V(8); PG8_WAIT_L(0); PG8_BAR; PG8_MMA(1, 0, At, B0); PG8_MMA(1, 1, At, B1); PG8_BAR; PG8_SCHED;
            PG8_LDB(B0, 1, 0); PG8_LDB(B1, 1, 1); PG8_SCHED; PG8_LDA(At, 1, 0); PG8_STAGE(PG8_SA(0, 1), a2 + hA, voffA);
            PG8_WAIT_V(8); PG8_WAIT_L(0); PG8_BAR; PG8_MMA(0, 0, At, B0); PG8_MMA(0, 1, At, B1); PG8_BAR; PG8_SCHED;
            PG8_LDA(At, 1, 1); PG8_STAGE(PG8_SB(1, 0), b3, voffB); PG8_STAGE(PG8_SB(1, 1), b3 + hB, voffB); PG8_STAGE(PG8_SA(1, 0), a3, voffA);
            PG8_WAIT_V(8); PG8_WAIT_L(0); PG8_BAR; PG8_MMA(1, 0, At, B0); PG8_MMA(1, 1, At, B1); PG8_BAR; PG8_SCHED;
            } else {
            PG8_LDB(B0, 0, 0); PG8_SCHED; PG8_LDA(At, 0, 0); PG8_STAGE(PG8_SA(1, 1), a1 + hA, voffA);
            PG8_WAIT_L(8); PG8_BAR; PG8_WAIT_L(0); PG8_MMA(0, 0, At, B0); PG8_BAR; PG8_SCHED;
            PG8_LDB(B1, 0, 1); PG8_STAGE(PG8_SB(0, 0), b2, voffB);
            PG8_BAR; PG8_WAIT_L(0); PG8_MMA(0, 1, At, B1); PG8_BAR;
            PG8_LDA(At, 0, 1); PG8_STAGE(PG8_SA(0, 0), a2, voffA);
            PG8_BAR; PG8_WAIT_L(0); PG8_MMA(1, 0, At, B0); PG8_BAR; PG8_SCHED;
            PG8_STAGE(PG8_SB(0, 1), b2 + hB, voffB);
            PG8_WAIT_V(6); PG8_BAR; PG8_MMA(1, 1, At, B1); PG8_BAR;
            PG8_LDB(B0, 1, 0); PG8_SCHED; PG8_LDA(At, 1, 0); PG8_STAGE(PG8_SA(0, 1), a2 + hA, voffA);
            PG8_WAIT_L(8); PG8_BAR; PG8_WAIT_L(0); PG8_MMA(0, 0, At, B0); PG8_BAR; PG8_SCHED;
            PG8_LDB(B1, 1, 1); PG8_STAGE(PG8_SB(1, 0), b3, voffB);
            PG8_BAR; PG8_WAIT_L(0); PG8_MMA(0, 1, At, B1); PG8_BAR;
            PG8_LDA(At, 1, 1); PG8_STAGE(PG8_SA(1, 0), a3, voffA);
            PG8_BAR; PG8_WAIT_L(0); PG8_MMA(1, 0, At, B0); PG8_BAR; PG8_SCHED;
            PG8_STAGE(PG8_SB(1, 1), b3 + hB, voffB);
            PG8_WAIT_V(6); PG8_BAR; PG8_MMA(1, 1, At, B1); PG8_BAR;
            }
        }
        if constexpr (ALIGN_EPI) { if (wr == 0) PG8_BAR; }
        { int fr_e = fr, fq_e = fq; asm volatile("" : "+v"(fr_e), "+v"(fq_e));
          E(acc, cur, wr, wc, fr_e, fq_e); } S.done(cur);
        if (!has_next) break;
#pragma unroll
        for (int a = 0; a < 2; ++a)
#pragma unroll
            for (int b = 0; b < 2; ++b)
#pragma unroll
                for (int m = 0; m < 4; ++m)
#pragma unroll
                    for (int n = 0; n < 2; ++n) acc[a][b][m][n] = (f32x4){0.f, 0.f, 0.f, 0.f};
        cur = nxt; cA = nA; cB = nB; ++ui;
        if constexpr (ALIGN_EPI) { if (wr == 1) PG8_BAR; }
    }
    PG8_WAIT_V(0);
    if constexpr (!ALIGN_EPI) { if (wr == 0) PG8_BAR; }
    PG8_BAR;
#undef PG8_SA
#undef PG8_SB
#undef PG8_STAGE
#undef PG8_LDA
#undef PG8_LDB
#undef PG8_MMA
#undef PG8_WAIT_V
#undef PG8_WAIT_L
#undef PG8_BAR
#undef PG8_SCHED
}
}

using pg8::bf16_t; using pg8::f32x4; using pg8::f32x2; using pg8::u32x4; using pg8::u32x2; using pg8::Unit;
constexpr int BATCH = 8, SEQ = 4096, D = 1024, M = BATCH * SEQ, FF = 4096, DEPTH = 4;
constexpr int MH = M / 2;
constexpr int RIN = 6144, VD = 2048;
constexpr float RMS_EPS = 1e-6f, LN_EPS = 1e-5f;
#define L2G0 (-0.04580368961312479f)
#define L2G1 (-0.02272007650008353f)
#define L2G2 (-0.011315313227834146f)
#define L2G3 (-0.005646563141142063f)
__device__ __forceinline__ float l2gamma(int h) { return h == 0 ? L2G0 : (h == 1 ? L2G1 : (h == 2 ? L2G2 : L2G3)); }

__device__ __forceinline__ float shfl_x(float v, int o, int lane) { return __int_as_float(__builtin_amdgcn_ds_bpermute((lane ^ o) << 2, __float_as_int(v))); }
__device__ __forceinline__ float wave_sum(float v, int lane) {
#pragma unroll
    for (int o = 1; o < 64; o <<= 1) v += shfl_x(v, o, lane);
    return v;
}
constexpr size_t MiB = 1u << 20;
constexpr size_t WS_CTL = 0, CTL_ZERO_BYTES = 1 * MiB;
constexpr size_t WS_GST = 8 * MiB;
constexpr size_t WS_W = 16 * MiB;
constexpr size_t WS_ROT = 56 * MiB;
constexpr size_t WS_A = 88 * MiB;
constexpr size_t WS_Y = WS_A;
constexpr size_t WS_XB = 152 * MiB;
constexpr size_t WS_R = 216 * MiB;
constexpr size_t WS_END = 472 * MiB;
constexpr int CW_BAR = 4096;

constexpr int RING_BYTES = 131072;
constexpr int LDSCTL_OFF = RING_BYTES, MISC_OFF = LDSCTL_OFF + 320;
constexpr int LDS_BYTES = 147456;
constexpr int NWAVES = 8;

#define GAS __attribute__((address_space(1)))
#define LAS __attribute__((address_space(3)))
typedef GAS unsigned gu32;

#define XB_TMO      128
#define XB_XCNT(j)  (256  + 64 * (j))
#define XB_XSUB(j)  (1280 + 64 * (j))
#define XB_XGEN(j)  (2304 + 64 * (j))
#define XB_TOP      3328
#define XB_TOPGEN   3392
#define XCD_BAR_WORDS 3456
#define XB_SPIN_CAP (1u << 18)
__device__ __forceinline__ unsigned xb_ld(unsigned* p)              { return __hip_atomic_load(p, __ATOMIC_RELAXED, __HIP_MEMORY_SCOPE_AGENT); }
__device__ __forceinline__ unsigned xb_add(unsigned* p, unsigned v) { return __hip_atomic_fetch_add(p, v, __ATOMIC_RELAXED, __HIP_MEMORY_SCOPE_AGENT); }
__device__ __forceinline__ unsigned xb_xcc_id() { return (unsigned)__builtin_amdgcn_s_getreg((3 << 11) | 20) & 0xFu; }
#define XB_SPIN(cond, bar) do { unsigned _sp = 0; while (cond) { __builtin_amdgcn_s_sleep(1); \
    if ((++_sp & 255u) == 0u) { if (xb_ld(&(bar)[XB_TMO])) break; if (_sp > XB_SPIN_CAP) { atomicAdd(&(bar)[XB_TMO], 1u); break; } } } } while (0)
struct XcdBarrier { unsigned* bar; unsigned x; volatile LAS unsigned* st; };
__device__ __forceinline__ XcdBarrier xcd_barrier_post(unsigned* bar, volatile LAS unsigned* st) {
    XcdBarrier b; b.bar = bar; b.x = xb_xcc_id(); b.st = st;
    if (threadIdx.x == 0) (void)xb_add(&bar[XB_XCNT(b.x)], 1u);
    return b;
}
__device__ __forceinline__ void xcd_barrier_complete(unsigned* bar, unsigned x, unsigned& nloc, unsigned& nx) {
    const unsigned G = gridDim.x * gridDim.y * gridDim.z;
    unsigned sum, cnt, mine, sp = 0u;
    for (;;) {
        sum = 0u; cnt = 0u; mine = 0u;
#pragma unroll
        for (unsigned j = 0; j < 16; ++j) { const unsigned c = xb_ld(&bar[XB_XCNT(j)]); sum += c; cnt += (c > 0u) ? 1u : 0u; mine = (j == x) ? c : mine; }
        if (sum == G) break;
        __builtin_amdgcn_s_sleep(1);
        if ((++sp & 255u) == 0u) { if (xb_ld(&bar[XB_TMO])) break; if (sp > XB_SPIN_CAP) { atomicAdd(&bar[XB_TMO], 1u); break; } }
    }
    nloc = mine > 0u ? mine : 1u; nx = cnt > 0u ? cnt : 1u;
}
__device__ __forceinline__ void xcd_barrier(const XcdBarrier& b) {
    asm volatile("s_waitcnt vmcnt(0)" ::: "memory");
    __syncthreads();
    if (threadIdx.x == 0) {
        unsigned* bar = b.bar;
        __builtin_amdgcn_s_waitcnt(0);
        unsigned nloc = b.st[0], nx = b.st[1];
        if (nloc == 0u) { xcd_barrier_complete(bar, b.x, nloc, nx); b.st[0] = nloc; b.st[1] = nx; }
        const unsigned old = xb_add(&bar[XB_XSUB(b.x)], 1u);
        const unsigned gen = old / nloc;
        if (old + 1u == (gen + 1u) * nloc) {
            __builtin_amdgcn_fence(__ATOMIC_RELEASE, "agent");
            asm volatile("s_waitcnt vmcnt(0)" ::: "memory");
            const unsigned og = xb_add(&bar[XB_TOP], 1u);
            const unsigned tg = og / nx;
            if (og + 1u == (tg + 1u) * nx) xb_add(&bar[XB_TOPGEN], 1u);
            else XB_SPIN(xb_ld(&bar[XB_TOPGEN]) == tg, bar);
            __builtin_amdgcn_fence(__ATOMIC_ACQUIRE, "agent");
            xb_add(&bar[XB_XGEN(b.x)], 1u);
            asm volatile("s_waitcnt vmcnt(0)" ::: "memory");
        } else {
            XB_SPIN(xb_ld(&bar[XB_XGEN(b.x)]) == gen, bar);
            __builtin_amdgcn_fence(__ATOMIC_ACQUIRE, "agent");
            asm volatile("s_waitcnt vmcnt(0)" ::: "memory");
        }
    }
    __syncthreads();
}

struct SchedStd : pg8::Ord {
    const char* A; const char* B; size_t sa, sb;
    __device__ __forceinline__ const char* a_ptr(const Unit& u) const { return A + (size_t)u.pm * sa; }
    __device__ __forceinline__ const char* b_ptr(const Unit& u) const { return B + (size_t)u.pn * sb; }
};
struct SchedR1 : pg8::Ord {
    const char* QP; const char* KK;
    __device__ __forceinline__ const char* a_ptr(const Unit& u) const { return QP + ((size_t)u.pm * 256 * 2048 + (size_t)u.pn * 512 + 256) * 2; }
    __device__ __forceinline__ const char* b_ptr(const Unit& u) const { return KK + ((size_t)u.pm * 256 * 1024 + (size_t)u.pn * 256) * 2; }
};
struct SchedR2 : pg8::Ord {
    const char* BC; const char* KT;
    __device__ __forceinline__ const char* a_ptr(const Unit& u) const { return BC + ((size_t)u.pm * 4 * 512 * 512 + (size_t)u.pn * 256 * 512) * 2; }
    __device__ __forceinline__ const char* b_ptr(const Unit& u) const { return KT + ((size_t)(u.pn >> 1) * 256 * MH + (size_t)u.pm * 256) * 2; }
};
struct SchedR4 : pg8::Ord {
    const char* QP; const char* BC;
    __device__ __forceinline__ const char* a_ptr(const Unit& u) const { return QP + ((size_t)u.pm * 256 * 2048 + (size_t)(u.pn >> 1) * 512) * 2; }
    __device__ __forceinline__ const char* b_ptr(const Unit& u) const { return BC + ((size_t)u.pm * 4 * 512 * 512 + (size_t)u.pn * 256 * 512) * 2; }
};

template <int ACT> struct EpiStore {
    static constexpr bool PERM = true;
    bf16_t* O; int ldc; const float* bias; int nostore;
    __device__ __forceinline__ void operator()(const f32x4 (&acc)[2][2][4][2], const Unit& u, int wr, int wc, int fr, int fq) const {
        const int row0 = u.pm * 256 + wr * 64 + fr, col0 = u.pn * 256 + wc * 32 + 8 * fq;
        f32x4 bv[2][2];
#pragma unroll
        for (int bj = 0; bj < 2; ++bj)
#pragma unroll
            for (int n = 0; n < 2; ++n) bv[bj][n] = bias ? *(const f32x4*)(bias + col0 + bj * 128 + 4 * n) : (f32x4){0.f, 0.f, 0.f, 0.f};
#pragma unroll
        for (int ai = 0; ai < 2; ++ai)
#pragma unroll
            for (int m = 0; m < 4; ++m) { bf16_t* rowp = O + (size_t)(row0 + ai * 128 + m * 16) * ldc + col0;
#pragma unroll
                for (int bj = 0; bj < 2; ++bj) { f32x4 v0 = acc[ai][bj][m][0] + bv[bj][0], v1 = acc[ai][bj][m][1] + bv[bj][1];
                    if (ACT == 1) {
#pragma unroll
                        for (int j = 0; j < 4; ++j) { const float a = fmaxf(v0[j], 0.f), b = fmaxf(v1[j], 0.f); v0[j] = a * a; v1[j] = b * b; } }
                    const u32x4 pw = pg8::pack8(v0, v1); if (!nostore) *(u32x4*)(rowp + bj * 128) = pw; else asm volatile("" :: "v"(pw)); } }
    }
};
struct EpiGLU {
    static constexpr bool PERM = true;
    bf16_t* O; const float* bias;
    __device__ __forceinline__ void operator()(const f32x4 (&acc)[2][2][4][2], const Unit& u, int wr, int wc, int fr, int fq) const {
        const int row0 = u.pm * 256 + wr * 64 + fr, col = u.pn * 128 + wc * 32 + 8 * fq;
        f32x4 ba[2], bg[2];
#pragma unroll
        for (int n = 0; n < 2; ++n) { ba[n] = *(const f32x4*)(bias + col + 4 * n); bg[n] = *(const f32x4*)(bias + 1024 + col + 4 * n); }
#pragma unroll
        for (int ai = 0; ai < 2; ++ai)
#pragma unroll
            for (int m = 0; m < 4; ++m) { bf16_t* rowp = O + (size_t)(row0 + ai * 128 + m * 16) * 1024 + col;
                f32x4 v[2];
#pragma unroll
                for (int n = 0; n < 2; ++n) { const f32x4 a = acc[ai][0][m][n] + ba[n], g = acc[ai][1][m][n] + bg[n];
#pragma unroll
                    for (int j = 0; j < 4; ++j) v[n][j] = a[j] * pg8::fast_sigmoid(g[j]); }
                *(u32x4*)rowp = pg8::pack8(v[0], v[1]); }
    }
};
struct EpiSC {
    static constexpr bool PERM = true;
    bf16_t* GB; bf16_t* GCH;
    __device__ __forceinline__ void operator()(const f32x4 (&acc)[2][2][4][2], const Unit& u, int wr, int wc, int fr, int fq) const {
        const int row0 = u.pm * 256 + wr * 64 + fr;
        if (u.pn < 4) {
            const int col0 = u.pn * 256 + wc * 32 + 8 * fq;
#pragma unroll
            for (int ai = 0; ai < 2; ++ai)
#pragma unroll
                for (int m = 0; m < 4; ++m) { bf16_t* rowp = GB + (size_t)(row0 + ai * 128 + m * 16) * 1024 + col0;
#pragma unroll
                    for (int bj = 0; bj < 2; ++bj) *(u32x4*)(rowp + bj * 128) = pg8::pack8(acc[ai][bj][m][0], acc[ai][bj][m][1]); }
        } else {
            const int col = (u.pn - 4) * 128 + wc * 32 + 8 * fq;
#pragma unroll
            for (int ai = 0; ai < 2; ++ai)
#pragma unroll
                for (int m = 0; m < 4; ++m) { bf16_t* rowp = GCH + (size_t)(row0 + ai * 128 + m * 16) * 1024 + col;
                    *(u32x4*)rowp = pg8::pack8(acc[ai][0][m][0] * acc[ai][1][m][0], acc[ai][0][m][1] * acc[ai][1][m][1]); }
        }
    }
};
struct EpiRetN {
    static constexpr bool PERM = true;
    bf16_t* QP; bf16_t* KK; bf16_t* KT; const f32x2* ROT;
    __device__ __forceinline__ void operator()(const f32x4 (&acc)[2][2][4][2], const Unit& u, int wr, int wc, int fr, int fq) const {
        const int h = u.pn & 3; const bool isk = u.pn >= 4;
        const float l2g = isk ? l2gamma(h) : 0.f, scb = isk ? 0.0625f : 1.0f;
        bf16_t* base = isk ? (KK + h * 256) : (QP + h * 512 + 256); const int pitch = isk ? 1024 : 2048;
        const int f0 = wc * 32 + 8 * fq;
#pragma unroll
        for (int ai = 0; ai < 2; ++ai) {
            f32x4 t[4][4];
#pragma unroll
            for (int m = 0; m < 4; ++m) { const size_t ml = (size_t)u.pm * 256 + ai * 128 + wr * 64 + m * 16 + fr; const f32x4* rt = (const f32x4*)(ROT + ml * 128 + f0);
#pragma unroll
                for (int q = 0; q < 4; ++q) t[m][q] = rt[q]; }
#pragma unroll
            for (int m = 0; m < 4; ++m) {
                const int r = ai * 128 + wr * 64 + m * 16 + fr; const size_t ml = (size_t)u.pm * 256 + r;
                const float cs[8] = {t[m][0][0], t[m][0][2], t[m][1][0], t[m][1][2], t[m][2][0], t[m][2][2], t[m][3][0], t[m][3][2]};
                const float sn[8] = {t[m][0][1], t[m][0][3], t[m][1][1], t[m][1][3], t[m][2][1], t[m][2][3], t[m][3][1], t[m][3][3]};
                const float sc = scb * __builtin_amdgcn_exp2f(-(float)(r + 1) * l2g);
                f32x4 o1[2], o2[2];
#pragma unroll
                for (int n = 0; n < 2; ++n)
#pragma unroll
                    for (int j = 0; j < 4; ++j) { const float x1 = acc[ai][0][m][n][j], x2 = acc[ai][1][m][n][j], c = cs[4 * n + j], s = sn[4 * n + j];
                        o1[n][j] = (x1 * c - x2 * s) * sc; o2[n][j] = (x2 * c + x1 * s) * sc; }
                const u32x4 w1 = pg8::pack8(o1[0], o1[1]), w2 = pg8::pack8(o2[0], o2[1]);
                bf16_t* dst = base + ml * pitch + f0;
                *(u32x4*)dst = w1; *(u32x4*)(dst + 128) = w2;
                if (isk) {
                    bf16_t* kt = KT + (size_t)(h * 256 + f0) * MH + ml;
                    const unsigned a1[4] = {w1.x, w1.y, w1.z, w1.w}, a2[4] = {w2.x, w2.y, w2.z, w2.w};
#pragma unroll
                    for (int e = 0; e < 4; ++e) {
                        kt[(size_t)(2 * e) * MH] = (bf16_t)(a1[e] & 0xffffu); kt[(size_t)(2 * e + 1) * MH] = (bf16_t)(a1[e] >> 16);
                        kt[(size_t)(128 + 2 * e) * MH] = (bf16_t)(a2[e] & 0xffffu); kt[(size_t)(128 + 2 * e + 1) * MH] = (bf16_t)(a2[e] >> 16); }
                }
            }
        }
    }
};
struct EpiRetT {
    static constexpr bool PERM = true;
    bf16_t* BC;
    __device__ __forceinline__ void operator()(const f32x4 (&acc)[2][2][4][2], const Unit& u, int wr, int wc, int fr, int fq) const {
        const int pv = u.pm, pt = u.pn, h = pv >> 1, dvb = (pv & 1) * 256; const int c0 = wc * 32 + 8 * fq;
#pragma unroll
        for (int ai = 0; ai < 2; ++ai)
#pragma unroll
            for (int m = 0; m < 4; ++m) { const int dv = dvb + ai * 128 + wr * 64 + m * 16 + fr;
                bf16_t* rowp = BC + ((size_t)(pt * 4 + h) * 512 + dv) * 512 + c0;
#pragma unroll
                for (int bj = 0; bj < 2; ++bj) *(u32x4*)(rowp + bj * 128) = pg8::pack8(acc[ai][bj][m][0], acc[ai][bj][m][1]); }
    }
};
struct EpiS {
    static constexpr bool PERM = true;
    bf16_t* QP;
    __device__ __forceinline__ void operator()(const f32x4 (&acc)[2][2][4][2], const Unit& u, int wr, int wc, int fr, int fq) const {
        const int h = u.pn;
#pragma unroll
        for (int ai = 0; ai < 2; ++ai)
#pragma unroll
            for (int m = 0; m < 4; ++m) { const int i = ai * 128 + wr * 64 + m * 16 + fr;
                bf16_t* rowp = QP + ((size_t)u.pm * 256 + i) * 2048 + h * 512;
#pragma unroll
                for (int bj = 0; bj < 2; ++bj) { const int j0 = bj * 128 + wc * 32 + 8 * fq; f32x4 v0 = acc[ai][bj][m][0], v1 = acc[ai][bj][m][1];
#pragma unroll
                    for (int jj = 0; jj < 4; ++jj) {
                        v0[jj] = __uint_as_float(__float_as_uint(v0[jj]) & ~(unsigned)((i - (j0 + jj)) >> 31));
                        v1[jj] = __uint_as_float(__float_as_uint(v1[jj]) & ~(unsigned)((i - (j0 + 4 + jj)) >> 31)); }
                    *(u32x4*)(rowp + j0) = pg8::pack8(v0, v1); } }
    }
};
struct EpiKV {
    static constexpr bool PERM = true;
    bf16_t* BC;
    __device__ __forceinline__ void operator()(const f32x4 (&acc)[2][2][4][2], const Unit& u, int wr, int wc, int fr, int fq) const {
        const int h = u.pn >> 1, t = u.pn & 1;
#pragma unroll
        for (int ai = 0; ai < 2; ++ai)
#pragma unroll
            for (int m = 0; m < 4; ++m) { const int r = ai * 128 + wr * 64 + m * 16 + fr;
                bf16_t* rowp = BC + ((size_t)(u.pm * 4 + h) * 512 + t * 256 + r) * 512 + 256 + wc * 32 + 8 * fq;
#pragma unroll
                for (int bj = 0; bj < 2; ++bj) *(u32x4*)(rowp + bj * 128) = pg8::pack8(acc[ai][bj][m][0], acc[ai][bj][m][1]); }
    }
};
struct EpiO {
    static constexpr bool PERM = true;
    bf16_t* O; f32x2* GST;
    __device__ __forceinline__ void operator()(const f32x4 (&acc)[2][2][4][2], const Unit& u, int wr, int wc, int fr, int fq) const {
        const int h = u.pn >> 1, t = u.pn & 1; const float l2g = l2gamma(h); const int ln = fr | (fq << 4);
#pragma unroll
        for (int ai = 0; ai < 2; ++ai)
#pragma unroll
            for (int m = 0; m < 4; ++m) { const int i = ai * 128 + wr * 64 + m * 16 + fr; const size_t ml = (size_t)u.pm * 256 + i;
                const float sc = __builtin_amdgcn_exp2f((float)(i + 1) * l2g);
                bf16_t* rowp = O + ml * 2048 + h * 512 + t * 256 + wc * 32 + 8 * fq;
                float s1 = 0.f, s2 = 0.f;
#pragma unroll
                for (int bj = 0; bj < 2; ++bj) { const f32x4 v0 = acc[ai][bj][m][0] * sc, v1 = acc[ai][bj][m][1] * sc;
                    s1 += (v0[0] + v0[1]) + (v0[2] + v0[3]) + (v1[0] + v1[1]) + (v1[2] + v1[3]);
                    s2 += (v0[0] * v0[0] + v0[1] * v0[1]) + (v0[2] * v0[2] + v0[3] * v0[3]) + (v1[0] * v1[0] + v1[1] * v1[1]) + (v1[2] * v1[2] + v1[3] * v1[3]);
                    *(u32x4*)(rowp + bj * 128) = pg8::pack8(v0, v1); }
                s1 += shfl_x(s1, 16, ln); s1 += shfl_x(s1, 32, ln); s2 += shfl_x(s2, 16, ln); s2 += shfl_x(s2, 32, ln);
                if (fq == 0) GST[ml * 32 + h * 8 + t * 4 + wc] = (f32x2){s1, s2};
            }
    }
};
struct EpiG {
    static constexpr bool PERM = true;
    bf16_t* O; const f32x2* GST; const float* gng;
    __device__ __forceinline__ void operator()(const f32x4 (&acc)[2][2][4][2], const Unit& u, int wr, int wc, int fr, int fq) const {
        const int h = u.pn >> 1, colb = u.pn * 256 + wc * 32 + 8 * fq;
        f32x4 g[2][2];
#pragma unroll
        for (int bj = 0; bj < 2; ++bj)
#pragma unroll
            for (int n = 0; n < 2; ++n) g[bj][n] = *(const f32x4*)(gng + colb + bj * 128 + 4 * n);
#pragma unroll
        for (int ai = 0; ai < 2; ++ai) {
            float mean[4], rstd[4]; u32x4 ow[4][2];
            { f32x4 st[4][4];
#pragma unroll
              for (int m = 0; m < 4; ++m) { const size_t ml = (size_t)u.pm * 256 + ai * 128 + wr * 64 + m * 16 + fr; const f32x4* sp = (const f32x4*)(GST + ml * 32 + h * 8);
#pragma unroll
                  for (int q = 0; q < 4; ++q) st[m][q] = sp[q]; }
#pragma unroll
              for (int m = 0; m < 4; ++m) {
                  const float S1 = (st[m][0][0] + st[m][0][2]) + (st[m][1][0] + st[m][1][2]) + (st[m][2][0] + st[m][2][2]) + (st[m][3][0] + st[m][3][2]);
                  const float S2 = (st[m][0][1] + st[m][0][3]) + (st[m][1][1] + st[m][1][3]) + (st[m][2][1] + st[m][2][3]) + (st[m][3][1] + st[m][3][3]);
                  mean[m] = S1 * (1.0f / 512.0f); const float var = fmaxf(S2 * (1.0f / 512.0f) - mean[m] * mean[m], 0.f); rstd[m] = __builtin_amdgcn_rsqf(var + LN_EPS); } }
            asm volatile("" : "+v"(mean[0]), "+v"(mean[1]), "+v"(mean[2]), "+v"(mean[3]), "+v"(rstd[0]), "+v"(rstd[1]), "+v"(rstd[2]), "+v"(rstd[3]));
#pragma unroll
            for (int m = 0; m < 4; ++m) { const size_t ml = (size_t)u.pm * 256 + ai * 128 + wr * 64 + m * 16 + fr; const bf16_t* rowp = O + ml * 2048 + colb;
#pragma unroll
                for (int bj = 0; bj < 2; ++bj) ow[m][bj] = *(const u32x4*)(rowp + bj * 128); }
#pragma unroll
            for (int m = 0; m < 4; ++m) { const size_t ml = (size_t)u.pm * 256 + ai * 128 + wr * 64 + m * 16 + fr; bf16_t* rowp = O + ml * 2048 + colb;
#pragma unroll
                for (int bj = 0; bj < 2; ++bj) { const u32x4 w = ow[m][bj];
                    const float o[8] = {pg8::bf_lo(w.x), pg8::bf_hi(w.x), pg8::bf_lo(w.y), pg8::bf_hi(w.y), pg8::bf_lo(w.z), pg8::bf_hi(w.z), pg8::bf_lo(w.w), pg8::bf_hi(w.w)};
                    f32x4 v[2];
#pragma unroll
                    for (int n = 0; n < 2; ++n)
#pragma unroll
                        for (int j = 0; j < 4; ++j) { const float a = acc[ai][bj][m][n][j]; v[n][j] = (o[4 * n + j] - mean[m]) * rstd[m] * g[bj][n][j] * (a * pg8::fast_sigmoid(a)); }
                    *(u32x4*)(rowp + bj * 128) = pg8::pack8(v[0], v[1]); } }
        }
    }
};

template <bool HAS_Y, bool HAS_A, bool XIN_F32, bool XOUT_F32>
__device__ __forceinline__ void thin_norm(const bf16_t* y, const void* xin, void* xout, const float* gpost, const float* gpre, bf16_t* aout, int gw, int NGW, int lane) {
    f32x4 gp[4], gq[4];
#pragma unroll
    for (int j = 0; j < 4; ++j) { gp[j] = HAS_Y ? *(const f32x4*)(gpost + 4 * lane + 256 * j) : (f32x4){0.f, 0.f, 0.f, 0.f}; gq[j] = HAS_A ? *(const f32x4*)(gpre + 4 * lane + 256 * j) : (f32x4){0.f, 0.f, 0.f, 0.f}; }
    for (int m0 = gw; m0 < M; m0 += 2 * NGW) {
        f32x4 xv[2][4], yv[2][4];
#pragma unroll
        for (int r = 0; r < 2; ++r) { const size_t m = (size_t)m0 + (size_t)r * NGW;
#pragma unroll
            for (int j = 0; j < 4; ++j) {
                if constexpr (XIN_F32) xv[r][j] = *(const f32x4*)((const float*)xin + m * D + 4 * lane + 256 * j);
                else { const u32x2 w = *(const u32x2*)((const bf16_t*)xin + m * D + 4 * lane + 256 * j); xv[r][j] = (f32x4){pg8::bf_lo(w.x), pg8::bf_hi(w.x), pg8::bf_lo(w.y), pg8::bf_hi(w.y)}; }
                if constexpr (HAS_Y) { const u32x2 w = *(const u32x2*)(y + m * D + 4 * lane + 256 * j); yv[r][j] = (f32x4){pg8::bf_lo(w.x), pg8::bf_hi(w.x), pg8::bf_lo(w.y), pg8::bf_hi(w.y)}; } } }
#pragma unroll
        for (int r = 0; r < 2; ++r) { const size_t m = (size_t)m0 + (size_t)r * NGW;
            if constexpr (HAS_Y) {
                float ss = 0.f;
#pragma unroll
                for (int j = 0; j < 4; ++j) ss += (yv[r][j][0] * yv[r][j][0] + yv[r][j][1] * yv[r][j][1]) + (yv[r][j][2] * yv[r][j][2] + yv[r][j][3] * yv[r][j][3]);
                const float s1 = 1.0f / sqrtf(wave_sum(ss, lane) * (1.0f / D) + RMS_EPS);
#pragma unroll
                for (int j = 0; j < 4; ++j) xv[r][j] += yv[r][j] * s1 * gp[j];
#pragma unroll
                for (int j = 0; j < 4; ++j) {
                    if constexpr (XOUT_F32) *(f32x4*)((float*)xout + m * D + 4 * lane + 256 * j) = xv[r][j];
                    else { u32x2 w; w.x = pg8::cvt_pk_bf16(xv[r][j][0], xv[r][j][1]); w.y = pg8::cvt_pk_bf16(xv[r][j][2], xv[r][j][3]); *(u32x2*)((bf16_t*)xout + m * D + 4 * lane + 256 * j) = w;
                           xv[r][j] = (f32x4){pg8::bf_lo(w.x), pg8::bf_hi(w.x), pg8::bf_lo(w.y), pg8::bf_hi(w.y)}; } }
            }
            if constexpr (HAS_A) {
                float ss = 0.f;
#pragma unroll
                for (int j = 0; j < 4; ++j) ss += (xv[r][j][0] * xv[r][j][0] + xv[r][j][1] * xv[r][j][1]) + (xv[r][j][2] * xv[r][j][2] + xv[r][j][3] * xv[r][j][3]);
                const float s2 = 1.0f / sqrtf(wave_sum(ss, lane) * (1.0f / D) + RMS_EPS);
#pragma unroll
                for (int j = 0; j < 4; ++j) { const f32x4 o = xv[r][j] * s2 * gq[j]; u32x2 w; w.x = pg8::cvt_pk_bf16(o[0], o[1]); w.y = pg8::cvt_pk_bf16(o[2], o[3]);
                    *(u32x2*)(aout + m * D + 4 * lane + 256 * j) = w; }
            }
        }
    }
}

__device__ __forceinline__ int srccol(int mode, int n) {
    if (mode == 1) { const int t = n >> 8, r = n & 255; return r < 128 ? t * 128 + r : 1024 + t * 128 + (r - 128); }
    if (mode == 2) { if (n < 1024) return n; const int q = n - 1024, t = q >> 8, r = q & 255; return r < 128 ? 1024 + t * 128 + r : 2048 + t * 128 + (r - 128); }
    return n;
}
__device__ __forceinline__ unsigned f2bf(float f) { unsigned u = __float_as_uint(f); return (u + 0x7fffu + ((u >> 16) & 1u)) >> 16; }
__device__ __forceinline__ unsigned pk2(float lo, float hi) { return f2bf(lo) | (f2bf(hi) << 16); }
__device__ __forceinline__ void transpose_item(const float* W, int K, int N, bf16_t* WT, int mode, LAS float* scr, int item, int lane) {
    const int nblk = N / 32, kb = item / nblk, nb = item % nblk, k0 = 64 * kb, n0 = 32 * nb, s0 = srccol(mode, n0);
#pragma unroll 8
    for (int i = 0; i < 32; ++i) { const int kk = 2 * i + (lane >> 5); scr[kk * 33 + (lane & 31)] = W[(size_t)(k0 + kk) * N + s0 + (lane & 31)]; }
    asm volatile("s_waitcnt lgkmcnt(0)" ::: "memory");
    const int c = lane & 7;
#pragma unroll
    for (int j = 0; j < 4; ++j) { const int n = (lane >> 3) + 8 * j; const LAS float* s = scr + (8 * c) * 33 + n;
        u32x4 o; o.x = pk2(s[0 * 33], s[1 * 33]); o.y = pk2(s[2 * 33], s[3 * 33]); o.z = pk2(s[4 * 33], s[5 * 33]); o.w = pk2(s[6 * 33], s[7 * 33]);
        *(u32x4*)(WT + (size_t)(n0 + n) * K + k0 + 8 * c) = o; }
    asm volatile("s_waitcnt lgkmcnt(0)" ::: "memory");
}
__device__ __forceinline__ void convert_w(const float* W, int K, int N, bf16_t* WT, int mode, LAS float* scr, int gw, int NGW, int lane) {
    const int nitems = (K / 64) * (N / 32);
    for (int it = gw; it < nitems; it += NGW) transpose_item(W, K, N, WT, mode, scr, it, lane);
}

__device__ __forceinline__ void rot_phase(const int* pos, f32x2* ROT, int gtid, int NT) {
    for (int idx = gtid; idx < M * 128; idx += NT) {
        const int m = idx >> 7, f = idx & 127;
        double w = 1.0, b = 0.9305720409296989; int e = f;
#pragma unroll
        for (int k = 0; k < 7; ++k) { if (e & 1) w *= b; b *= b; e >>= 1; }
        const double ang = (double)pos[m] * w;
        const double kq = __builtin_rint(ang * 0.6366197723675814);
        double r = __builtin_fma(-kq, 1.5707963267948966, ang); r = __builtin_fma(-kq, 6.123233995736766e-17, r);
        const int q = (int)((long long)kq & 3);
        const double r2 = r * r;
        const double sp = r * (1.0 + r2 * (-1.0 / 6 + r2 * (1.0 / 120 + r2 * (-1.0 / 5040 + r2 * (1.0 / 362880 + r2 * (-1.0 / 39916800))))));
        const double cp = 1.0 + r2 * (-0.5 + r2 * (1.0 / 24 + r2 * (-1.0 / 720 + r2 * (1.0 / 40320 + r2 * (-1.0 / 3628800 + r2 * (1.0 / 479001600))))));
        const double c = (q == 0) ? cp : (q == 1) ? -sp : (q == 2) ? -cp : sp;
        const double s = (q == 0) ? sp : (q == 1) ? cp : (q == 2) ? -sp : -cp;
        ROT[idx] = (f32x2){(float)c, (float)s};
    }
}

__device__ __forceinline__ void scan_phase(bf16_t* BC, int G, int bid, int tid) {
    for (int it = bid * 512 + tid; it < 4 * 4 * 512 * 32; it += G * 512) {
        const int dk8 = it & 31, dv = (it >> 5) & 511, h = (it >> 14) & 3, bl = it >> 16;
        bf16_t* p = BC + ((size_t)((bl * 16) * 4 + h) * 512 + dv) * 512 + 256 + dk8 * 8;
        const size_t cs = (size_t)4 * 512 * 512;
        u32x4 kv[15];
#pragma unroll
        for (int c = 0; c < 15; ++c) kv[c] = *(const u32x4*)(p + c * cs);
        const float g256 = __builtin_amdgcn_exp2f(256.0f * l2gamma(h));
        float s[8];
#pragma unroll
        for (int k = 0; k < 8; ++k) s[k] = 0.f;
#pragma unroll
        for (int c = 0; c < 16; ++c) {
            u32x4 w; w.x = pg8::cvt_pk_bf16(s[0], s[1]); w.y = pg8::cvt_pk_bf16(s[2], s[3]); w.z = pg8::cvt_pk_bf16(s[4], s[5]); w.w = pg8::cvt_pk_bf16(s[6], s[7]);
            *(u32x4*)(p + c * cs) = w;
            if (c < 15) { const u32x4 q = kv[c];
                s[0] = g256 * (s[0] + pg8::bf_lo(q.x)); s[1] = g256 * (s[1] + pg8::bf_hi(q.x)); s[2] = g256 * (s[2] + pg8::bf_lo(q.y)); s[3] = g256 * (s[3] + pg8::bf_hi(q.y));
                s[4] = g256 * (s[4] + pg8::bf_lo(q.z)); s[5] = g256 * (s[5] + pg8::bf_hi(q.z)); s[6] = g256 * (s[6] + pg8::bf_lo(q.w)); s[7] = g256 * (s[7] + pg8::bf_hi(q.w)); }
        }
    }
}

__device__ __forceinline__ void cf_conv_phase(const bf16_t* HG, const float* wdw, const float* bdw, const float* lng, const float* lnb, bf16_t* out, LAS float* red, int G, int bid, int tid) {
    const int lane = tid & 63, wave = tid >> 6, c0 = 2 * tid;
    f32x2 w[31];
#pragma unroll
    for (int k = 0; k < 31; ++k) w[k] = *(const f32x2*)(wdw + k * 1024 + c0);
    const f32x2 bd = *(const f32x2*)(bdw + c0), lg = *(const f32x2*)(lng + c0), lb = *(const f32x2*)(lnb + c0);
    int itn = 0;
    for (int u = bid; u < M / 8; u += G, ++itn) {
        const int t0 = u * 8, s0 = t0 & (SEQ - 1);
        unsigned xr[38];
#pragma unroll
        for (int r = 0; r < 38; ++r) xr[r] = (s0 - 30 + r >= 0) ? *(const unsigned*)(HG + (size_t)(t0 - 30 + r) * 1024 + c0) : 0u;
        f32x2 acc[8];
#pragma unroll
        for (int i = 0; i < 8; ++i) acc[i] = bd;
#pragma unroll
        for (int r = 0; r < 38; ++r) { const float x0 = pg8::bf_lo(xr[r]), x1 = pg8::bf_hi(xr[r]);
#pragma unroll
            for (int i = 0; i < 8; ++i) { const int k = r - i; if (k >= 0 && k <= 30) { acc[i].x += w[k].x * x0; acc[i].y += w[k].y * x1; } } }
        float p[16];
#pragma unroll
        for (int i = 0; i < 8; ++i) { p[2 * i] = acc[i].x + acc[i].y; p[2 * i + 1] = acc[i].x * acc[i].x + acc[i].y * acc[i].y; }
#pragma unroll
        for (int i = 0; i < 16; ++i) p[i] = wave_sum(p[i], lane);
        LAS float* rb = red + (itn & 1) * 128;
        if (lane == 0) {
#pragma unroll
            for (int i = 0; i < 16; ++i) rb[wave * 16 + i] = p[i]; }
        __syncthreads();
#pragma unroll
        for (int i = 0; i < 8; ++i) { float s1 = 0.f, s2 = 0.f;
#pragma unroll
            for (int wv = 0; wv < 8; ++wv) { s1 += rb[wv * 16 + 2 * i]; s2 += rb[wv * 16 + 2 * i + 1]; }
            const float mean = s1 * (1.0f / 1024.0f); const float var = fmaxf(s2 * (1.0f / 1024.0f) - mean * mean, 0.f); const float rstd = 1.0f / sqrtf(var + LN_EPS);
            const float v0 = (acc[i].x - mean) * rstd * lg.x + lb.x, v1 = (acc[i].y - mean) * rstd * lg.y + lb.y;
            *(unsigned*)(out + (size_t)(t0 + i) * 1024 + c0) = pg8::cvt_pk_bf16(v0 * pg8::fast_sigmoid(v0), v1 * pg8::fast_sigmoid(v1)); }
    }
    __syncthreads();
}

__device__ __forceinline__ void sc_conv_phase(const bf16_t* GB, const bf16_t* GCH, const float* wcv, bf16_t* Z, int G, int bid, int tid) {
    const int cg = (tid & 127) * 8, rsub = tid >> 7;
    float w0[8], w1[8], w2[8];
#pragma unroll
    for (int j = 0; j < 8; ++j) { w0[j] = wcv[cg + j]; w1[j] = wcv[1024 + cg + j]; w2[j] = wcv[2048 + cg + j]; }
    for (int rbase = bid * 4; rbase < M; rbase += G * 4) {
        const int t = rbase + rsub, s = t & (SEQ - 1);
        const u32x4 z4 = (u32x4){0u, 0u, 0u, 0u};
        const u32x4 q2 = *(const u32x4*)(GCH + (size_t)t * 1024 + cg);
        const u32x4 q1 = s >= 1 ? *(const u32x4*)(GCH + (size_t)(t - 1) * 1024 + cg) : z4;
        const u32x4 q0 = s >= 2 ? *(const u32x4*)(GCH + (size_t)(t - 2) * 1024 + cg) : z4;
        const u32x4 gq = *(const u32x4*)(GB + (size_t)t * 1024 + cg);
        const unsigned a0[4] = {q0.x, q0.y, q0.z, q0.w}, a1[4] = {q1.x, q1.y, q1.z, q1.w}, a2[4] = {q2.x, q2.y, q2.z, q2.w}, ag[4] = {gq.x, gq.y, gq.z, gq.w};
        unsigned o[4];
#pragma unroll
        for (int k = 0; k < 4; ++k) {
            const float lo = pg8::bf_lo(ag[k]) * (w0[2 * k] * pg8::bf_lo(a0[k]) + w1[2 * k] * pg8::bf_lo(a1[k]) + w2[2 * k] * pg8::bf_lo(a2[k]));
            const float hi = pg8::bf_hi(ag[k]) * (w0[2 * k + 1] * pg8::bf_hi(a0[k]) + w1[2 * k + 1] * pg8::bf_hi(a1[k]) + w2[2 * k + 1] * pg8::bf_hi(a2[k]));
            o[k] = pg8::cvt_pk_bf16(lo, hi); }
        *(u32x4*)(Z + (size_t)t * 1024 + cg) = (u32x4){o[0], o[1], o[2], o[3]};
    }
}

struct Args { const float* in[19]; float* out; unsigned char* ws; int ph_lo, ph_hi; };
constexpr int NPHASES = 1 + 16 + 7 + 7 + 16;

__device__ __forceinline__ void convert_layer(const Args& args, int L, unsigned char* ws, LAS float* scr, int gw, int NGW, int lane) {
    bf16_t* WM1 = (bf16_t*)(ws + WS_W); bf16_t* WM2 = (bf16_t*)(ws + WS_W + 12 * MiB); bf16_t* W1 = (bf16_t*)(ws + WS_W + 16 * MiB); bf16_t* W2 = (bf16_t*)(ws + WS_W + 24 * MiB);
    const int kind = L % 3, j = L / 3;
    if (kind == 0) { convert_w(args.in[3] + (size_t)j * D * RIN, D, RIN, WM1, 0, scr, gw, NGW, lane); convert_w(args.in[5] + (size_t)j * VD * D, VD, D, WM2, 0, scr, gw, NGW, lane); }
    else if (kind == 1) { convert_w(args.in[6], D, 2 * D, WM1, 1, scr, gw, NGW, lane); convert_w(args.in[12], D, D, WM2, 0, scr, gw, NGW, lane); }
    else { convert_w(args.in[14], D, 3 * D, WM1, 2, scr, gw, NGW, lane); convert_w(args.in[16], D, D, WM2, 0, scr, gw, NGW, lane); }
    convert_w(args.in[17] + (size_t)L * D * FF, D, FF, W1, 0, scr, gw, NGW, lane);
    convert_w(args.in[18] + (size_t)L * FF * D, FF, D, W2, 0, scr, gw, NGW, lane);
}

__global__ void __launch_bounds__(NWAVES * 64, 2) trunk_fwd(Args args) {
    extern __shared__ __attribute__((aligned(16))) unsigned char lds_raw[];
    LAS unsigned char* lds = (LAS unsigned char*)lds_raw;
    volatile LAS unsigned* MISC = (volatile LAS unsigned*)(lds + MISC_OFF);
    const int tid0 = threadIdx.x;
    const int G = gridDim.x, bid = blockIdx.x;
    const int NGW = G * NWAVES;
    unsigned char* ws = args.ws;
    for (int u = tid0; u < (LDS_BYTES - LDSCTL_OFF) / 4; u += NWAVES * 64) ((LAS unsigned*)(lds + LDSCTL_OFF))[u] = 0u;
    __syncthreads();
    XcdBarrier bar = xcd_barrier_post((unsigned*)(ws + WS_CTL) + CW_BAR, MISC + 8);
    const int lo = args.ph_lo, hi = args.ph_hi;
    int ph = 0;
#define PH_BEGIN if (ph >= lo && ph < hi) { int tid = tid0; asm volatile("" : "+v"(tid)); const int lane = tid & 63, wave = __builtin_amdgcn_readfirstlane(tid >> 6), gw = bid * NWAVES + wave; LAS float* scr = (LAS float*)(lds + wave * 16384); (void)lane; (void)gw; (void)scr;
#define PH_END } if (ph >= lo && ph + 1 < hi) { xcd_barrier(bar); if (PROBE_BAR2) xcd_barrier(bar); } ++ph;

    const float* x_in = args.in[0]; const int* positions = (const int*)args.in[1]; const float* norm_g = args.in[2];
    bf16_t* xb = (bf16_t*)(ws + WS_XB);
    bf16_t* WM1 = (bf16_t*)(ws + WS_W); bf16_t* WM2 = (bf16_t*)(ws + WS_W + 12 * MiB); bf16_t* W1 = (bf16_t*)(ws + WS_W + 16 * MiB); bf16_t* W2 = (bf16_t*)(ws + WS_W + 24 * MiB);
    f32x2* ROT = (f32x2*)(ws + WS_ROT); f32x2* GST = (f32x2*)(ws + WS_GST);
    bf16_t* Abuf = (bf16_t*)(ws + WS_A); bf16_t* Ybuf = (bf16_t*)(ws + WS_Y);
    unsigned char* R = ws + WS_R;

    PH_BEGIN
        convert_layer(args, 0, ws, scr, gw, NGW, lane);
        rot_phase(positions, ROT, bid * 512 + tid, G * 512);
        thin_norm<false, true, true, false>(nullptr, x_in, nullptr, nullptr, norm_g, Abuf, gw, NGW, lane);
    PH_END

    for (int L = 0; L < DEPTH; ++L) {
        const int kind = L % 3, jl = L / 3;
        if (kind == 0) {
            const float* gng = args.in[4] + (size_t)jl * VD;
            bf16_t* BC = (bf16_t*)R; bf16_t* QP = (bf16_t*)(R + 128 * MiB); bf16_t* KK = (bf16_t*)(R + 192 * MiB); bf16_t* KT = (bf16_t*)(R + 224 * MiB); bf16_t* OH = (bf16_t*)(R + 192 * MiB);
            for (int half = 0; half < 2; ++half) {
                const bf16_t* ah = Abuf + (size_t)half * MH * D;
                const f32x2* roth = ROT + (size_t)half * MH * 128;
                f32x2* gsth = GST + (size_t)half * MH * 32;
                PH_BEGIN
                    { SchedStd S; S.init(64, 8, G, bid); S.A = (const char*)ah; S.sa = (size_t)256 * D * 2; S.B = (const char*)WM1; S.sb = (size_t)256 * D * 2;
                      EpiRetN E{QP, KK, KT, roth}; pg8::gemm_phase<EpiRetN, SchedStd, true, true>(lds, D, D, D, S, E); }
                    { SchedStd S; S.init(8, 64, G, bid); S.A = (const char*)(WM1 + (size_t)2048 * D); S.sa = (size_t)256 * D * 2; S.B = (const char*)ah; S.sb = (size_t)256 * D * 2;
                      EpiRetT E{BC}; pg8::gemm_phase<EpiRetT, SchedStd, true, true>(lds, D, D, D, S, E); }
                PH_END
                PH_BEGIN
                    { SchedR1 S; S.init(64, 4, G, bid); S.QP = (const char*)QP; S.KK = (const char*)KK;
                      EpiS E{QP}; pg8::gemm_phase<EpiS, SchedR1, true, true>(lds, 2048, 1024, 256, S, E); }
                    { SchedR2 S; S.init(64, 8, G, bid); S.BC = (const char*)BC; S.KT = (const char*)KT;
                      EpiKV E{BC}; pg8::gemm_phase<EpiKV, SchedR2, true, true>(lds, 512, MH, 256, S, E); }
                PH_END
                PH_BEGIN
                    scan_phase(BC, G, bid, tid);
                PH_END
                PH_BEGIN
                    { SchedR4 S; S.init(64, 8, G, bid); S.QP = (const char*)QP; S.BC = (const char*)BC;
                      EpiO E{OH, gsth}; pg8::gemm_phase<EpiO, SchedR4, true, true>(lds, 2048, 512, 512, S, E); }
                PH_END
                PH_BEGIN
                    { SchedStd S; S.init(64, 8, G, bid); S.A = (const char*)ah; S.sa = (size_t)256 * D * 2; S.B = (const char*)(WM1 + (size_t)4096 * D); S.sb = (size_t)256 * D * 2;
                      EpiG E{OH, gsth, gng}; pg8::gemm_phase<EpiG, SchedStd, true, true>(lds, D, D, D, S, E); }
                PH_END
                PH_BEGIN
                    { SchedStd S; S.init(64, 4, G, bid); S.A = (const char*)OH; S.sa = (size_t)256 * VD * 2; S.B = (const char*)WM2; S.sb = (size_t)256 * VD * 2;
                      EpiStore<0> E{Ybuf + (size_t)half * MH * D, D, nullptr, 0}; pg8::gemm_phase<EpiStore<0>, SchedStd, true, true>(lds, VD, VD, VD, S, E); }
                PH_END
            }
        } else if (kind == 1) {
            bf16_t* HG = (bf16_t*)R; bf16_t* ACF = (bf16_t*)(R + 64 * MiB);
            PH_BEGIN
                { SchedStd S; S.init(128, 8, G, bid); S.A = (const char*)Abuf; S.sa = (size_t)256 * D * 2; S.B = (const char*)WM1; S.sb = (size_t)256 * D * 2;
                  EpiGLU E{HG, args.in[7]}; pg8::gemm_phase<EpiGLU, SchedStd, true, true>(lds, D, D, D, S, E); }
            PH_END
            PH_BEGIN
                cf_conv_phase(HG, args.in[8], args.in[9], args.in[10], args.in[11], ACF, (LAS float*)lds, G, bid, tid);
            PH_END
            PH_BEGIN
                { SchedStd S; S.init(128, 4, G, bid); S.A = (const char*)ACF; S.sa = (size_t)256 * D * 2; S.B = (const char*)WM2; S.sb = (size_t)256 * D * 2;
                  EpiStore<0> E{Ybuf, D, args.in[13], 0}; pg8::gemm_phase<EpiStore<0>, SchedStd, true, true>(lds, D, D, D, S, E); }
            PH_END
        } else {
            bf16_t* GB = (bf16_t*)R; bf16_t* GCH = (bf16_t*)(R + 64 * MiB); bf16_t* Z = (bf16_t*)(R + 128 * MiB);
            PH_BEGIN
                { SchedStd S; S.init(128, 12, G, bid); S.A = (const char*)Abuf; S.sa = (size_t)256 * D * 2; S.B = (const char*)WM1; S.sb = (size_t)256 * D * 2;
                  EpiSC E{GB, GCH}; pg8::gemm_phase<EpiSC, SchedStd, true, true>(lds, D, D, D, S, E); }
            PH_END
            PH_BEGIN
                sc_conv_phase(GB, GCH, args.in[15], Z, G, bid, tid);
            PH_END
            PH_BEGIN
                { SchedStd S; S.init(128, 4, G, bid); S.A = (const char*)Z; S.sa = (size_t)256 * D * 2; S.B = (const char*)WM2; S.sb = (size_t)256 * D * 2;
                  EpiStore<0> E{Ybuf, D, nullptr, 0}; pg8::gemm_phase<EpiStore<0>, SchedStd, true, true>(lds, D, D, D, S, E); }
            PH_END
        }
        PH_BEGIN
            if (L == 0) thin_norm<true, true, true, false>(Ybuf, x_in, xb, norm_g + (size_t)(L * 4 + 1) * D, norm_g + (size_t)(L * 4 + 2) * D, Abuf, gw, NGW, lane);
            else thin_norm<true, true, false, false>(Ybuf, xb, xb, norm_g + (size_t)(L * 4 + 1) * D, norm_g + (size_t)(L * 4 + 2) * D, Abuf, gw, NGW, lane);
        PH_END
        bf16_t* H = (bf16_t*)R;
        PH_BEGIN
            for (int rep = 0; rep < ((PROBE_DUP & 1) ? 2 : 1); ++rep)
            { SchedStd S; S.init(128, 16, G, bid); S.A = (const char*)Abuf; S.sa = (size_t)256 * D * 2; S.B = (const char*)W1; S.sb = (size_t)256 * D * 2;
              EpiStore<1> E{H, FF, nullptr, (PROBE_DUP & 4) ? rep : 0}; pg8::gemm_phase<EpiStore<1>, SchedStd, true, true>(lds, D, D, D, S, E); }
        PH_END
        PH_BEGIN
            for (int rep = 0; rep < ((PROBE_DUP & 2) ? 2 : 1); ++rep)
            { SchedStd S; S.init(128, 4, G, bid); S.A = (const char*)H; S.sa = (size_t)256 * FF * 2; S.B = (const char*)W2; S.sb = (size_t)256 * FF * 2;
              EpiStore<0> E{Ybuf, D, nullptr, 0}; pg8::gemm_phase<EpiStore<0>, SchedStd, true, true>(lds, FF, FF, FF, S, E); }
        PH_END
        PH_BEGIN
            if (L + 1 < DEPTH) {
                thin_norm<true, true, false, false>(Ybuf, xb, xb, norm_g + (size_t)(L * 4 + 3) * D, norm_g + (size_t)((L + 1) * 4 + 0) * D, Abuf, gw, NGW, lane);
                convert_layer(args, L + 1, ws, scr, gw, NGW, lane);
            } else {
                thin_norm<true, false, false, true>(Ybuf, xb, args.out, norm_g + (size_t)(L * 4 + 3) * D, nullptr, nullptr, gw, NGW, lane);
            }
        PH_END
    }
#undef PH_BEGIN
#undef PH_END
}

extern "C" void kernel_launch(void* const* d_in, const int* in_sizes, int n_in, void* d_out, int out_size, void* d_ws, size_t ws_size, hipStream_t stream) {
    static int grid = 0;
    if (grid == 0) {
        if (n_in != 19 || out_size != M * D || ws_size < WS_END) { fprintf(stderr, "kernel_launch: unexpected problem shape (n_in %d, out %d, ws %zu)\n", n_in, out_size, ws_size); grid = -1; return; }
        int dev = 0, cus = 0, per_cu = 0;
        if (hipGetDevice(&dev) != hipSuccess || hipDeviceGetAttribute(&cus, hipDeviceAttributeMultiprocessorCount, dev) != hipSuccess) { grid = -1; return; }
        if (hipFuncSetAttribute((const void*)trunk_fwd, hipFuncAttributeMaxDynamicSharedMemorySize, LDS_BYTES) != hipSuccess) { fprintf(stderr, "kernel_launch: hipFuncSetAttribute failed\n"); grid = -1; return; }
        if (hipOccupancyMaxActiveBlocksPerMultiprocessor(&per_cu, (const void*)trunk_fwd, NWAVES * 64, LDS_BYTES) != hipSuccess || per_cu < 1)
            fprintf(stderr, "kernel_launch: occupancy query reports %d workgroups per CU\n", per_cu);
        (void)hipGetLastError();
        grid = cus;
    }
    if (grid < 0) return;
    if (hipMemsetAsync((char*)d_ws + WS_CTL, 0, CTL_ZERO_BYTES, stream) != hipSuccess) return;
    Args a{};
    for (int i = 0; i < 19; ++i) a.in[i] = (const float*)d_in[i];
    a.out = (float*)d_out; a.ws = (unsigned char*)d_ws;
#if MK_PER_PHASE
    for (int p = 0; p < NPHASES; ++p) { a.ph_lo = p; a.ph_hi = p + 1; hipLaunchKernelGGL(trunk_fwd, dim3(grid), dim3(NWAVES * 64), LDS_BYTES, stream, a); }
#else
    a.ph_lo = 0; a.ph_hi = NPHASES;
    hipLaunchKernelGGL(trunk_fwd, dim3(grid), dim3(NWAVES * 64), LDS_BYTES, stream, a);
#endif
}
```

```cpp
#include <hip/hip_runtime.h>
#include <cstdio>
#include <cstdint>

#ifndef MK_PER_PHASE
#define MK_PER_PHASE 0
#endif

namespace pg8 {
#define PG8_LAS __attribute__((address_space(3)))
typedef unsigned short bf16_t;
typedef short bf16x8 __attribute__((ext_vector_type(8)));
typedef float f32x4 __attribute__((ext_vector_type(4)));
typedef float f32x2 __attribute__((ext_vector_type(2)));
typedef unsigned u32x4 __attribute__((ext_vector_type(4)));
typedef unsigned u32x2 __attribute__((ext_vector_type(2)));
constexpr int BM = 256, BK = 64, HALF = 128, HTB = HALF * BK * 2, STAGE_BYTES = 8 * HTB, NXCD = 8, WGM = 8;

__host__ __device__ __forceinline__ int lds_byte(int r, int c) { const int st = (r >> 4) * 2 + (c >> 5), rr = r & 15, cc = c & 31, ob = rr * 64 + cc * 2; return st * 1024 + (ob ^ (((ob >> 9) & 1) << 5)); }
__host__ __device__ __forceinline__ void stage_rc(int b, int& R, int& C) { const int st = b / 1024, sb = b % 1024, swz = sb ^ (((sb >> 9) & 1) << 5); R = (st >> 1) * 16 + swz / 64; C = (st & 1) * 32 + (swz % 64) / 2; }
__host__ __device__ __forceinline__ int perm32(int rho) { const int n = rho >> 4, i = rho & 15; return 8 * (i >> 2) + 4 * n + (i & 3); }

struct Unit { int pm, pn, kind; };

struct Ord {
    int nM, nN, nwg, G, c;
    __device__ __forceinline__ void init(int nM_, int nN_, int G_, int c_) { nM = nM_; nN = nN_; nwg = nM * nN; G = G_; c = c_; }
    __device__ __forceinline__ bool next(int i, Unit& u) const {
        const long L = (long)i * G + c; if (L >= nwg) return false;
        int wgid = (int)L; { const int q = nwg / NXCD, r = nwg % NXCD, xcd = wgid % NXCD, off = wgid / NXCD; wgid = (xcd < r ? xcd * (q + 1) : r * (q + 1) + (xcd - r) * q) + off; }
        const int nig = WGM * nN, gid = wgid / nig, fm = gid * WGM, gsz = (nM - fm) < WGM ? (nM - fm) : WGM;
        u.pm = fm + ((wgid % nig) % gsz); u.pn = (wgid % nig) / gsz; u.kind = 0; return true;
    }
    __device__ __forceinline__ void a_ready(const Unit&) const {}
    __device__ __forceinline__ void done(const Unit&) const {}
};

struct OrdPanel {
    int nM, G, c;
    __device__ __forceinline__ void init(int nM_, int G_, int c_) { nM = nM_; G = G_; c = c_; }
    __device__ __forceinline__ bool next(int i, Unit& u) const {
        const int L = i * G + c; if (L >= nM * 4) return false;
        const int xcd = L & 7, j = L >> 3; u.pn = j & 3; u.pm = ((j >> 2) << 3) + xcd; u.kind = 0; return true;
    }
    __device__ __forceinline__ void a_ready(const Unit&) const {}
    __device__ __forceinline__ void done(const Unit&) const {}
};
struct OrdRound : Ord {
    int round;
    __device__ __forceinline__ bool next(int i, Unit& u) const { if (i != 0) return false; return Ord::next(round, u); }
};

__device__ __forceinline__ unsigned cvt_pk_bf16(float lo, float hi) { unsigned r; asm volatile("v_cvt_pk_bf16_f32 %0, %1, %2" : "=v"(r) : "v"(lo), "v"(hi)); return r; }
__device__ __forceinline__ u32x4 pack8(const f32x4 v0, const f32x4 v1) { u32x4 w; w.x = cvt_pk_bf16(v0[0], v0[1]); w.y = cvt_pk_bf16(v0[2], v0[3]); w.z = cvt_pk_bf16(v1[0], v1[1]); w.w = cvt_pk_bf16(v1[2], v1[3]); return w; }
__device__ __forceinline__ float bf_lo(unsigned w) { return __uint_as_float(w << 16); }
__device__ __forceinline__ float bf_hi(unsigned w) { return __uint_as_float(w & 0xffff0000u); }
__device__ __forceinline__ float fast_sigmoid(float x) { return __builtin_amdgcn_rcpf(1.0f + __builtin_amdgcn_exp2f(-1.44269504f * x)); }

template <class Epi, class Sched, bool ALIGN_EPI, bool SP2>
__device__ __forceinline__ void gemm_phase(PG8_LAS unsigned char* lds, const int tid_in, const int lda, const int ldb, const int K, const Sched& S, const Epi& E) {
    int tid_o = tid_in; asm volatile("" : "+v"(tid_o));
    const int tid = tid_o, wid = __builtin_amdgcn_readfirstlane(tid >> 6), lane = tid & 63, wr = wid >> 2, wc = wid & 3, fr = lane & 15, fq = lane >> 4;
    static_assert(8 + Epi::TAIL <= 63, "vmcnt has 6 bits");
    int nt = K / BK; asm volatile("" : "+s"(nt));
    unsigned voffA[2], voffB[2];
#pragma unroll
    for (int i = 0; i < 2; ++i) { int R, C; stage_rc(tid * 16 + i * 8192, R, C); const int Rb = Epi::PERM ? ((R & ~31) + perm32(R & 31)) : R;
        voffA[i] = (unsigned)(R * lda + C) * 2u; voffB[i] = (unsigned)(Rb * ldb + C) * 2u; }
    const size_t kstep = (size_t)(BK * 2);
    const size_t hA = (size_t)HALF * lda * 2, hB = (size_t)HALF * ldb * 2;
    const unsigned ldsw = (unsigned)wid * 1024u;
    const int aoff = lds_byte(wr * 64 + fr, fq * 8), boff = lds_byte(wc * 32 + fr, fq * 8);
#define PG8_SA(b, h) (((b) * 2 + (h)) * HTB)
#define PG8_SB(b, h) ((4 + (b) * 2 + (h)) * HTB)
#define PG8_STAGE(bufoff, gbase, voff) do { _Pragma("unroll") for (int _i = 0; _i < 2; ++_i) \
        __builtin_amdgcn_global_load_lds((const unsigned*)((const char*)(gbase) + (voff)[_i]), (PG8_LAS unsigned*)(lds + (bufoff) + ldsw + _i * 8192), 16, 0, 0); } while (0)
#define PG8_LDA(dst, b, h) do { _Pragma("unroll") for (int m = 0; m < 4; ++m) _Pragma("unroll") for (int k = 0; k < 2; ++k) dst[m][k] = *(const PG8_LAS bf16x8*)(lds + PG8_SA(b, h) + aoff + m * 2048 + k * 1024); } while (0)
#define PG8_LDB(dst, b, h) do { _Pragma("unroll") for (int n = 0; n < 2; ++n) _Pragma("unroll") for (int k = 0; k < 2; ++k) dst[n][k] = *(const PG8_LAS bf16x8*)(lds + PG8_SB(b, h) + boff + n * 2048 + k * 1024); } while (0)
#define PG8_MMA(ai, bj, At, Bt) do { __builtin_amdgcn_s_setprio(1); _Pragma("unroll") for (int m = 0; m < 4; ++m) _Pragma("unroll") for (int n = 0; n < 2; ++n) _Pragma("unroll") for (int k = 0; k < 2; ++k) \
        acc[ai][bj][m][n] = __builtin_amdgcn_mfma_f32_16x16x32_bf16(Bt[n][k], At[m][k], acc[ai][bj][m][n], 0, 0, 0); __builtin_amdgcn_s_setprio(0); } while (0)
#define PG8_WAIT_V(n) asm volatile("s_waitcnt vmcnt(" #n ")" ::: "memory")
#define PG8_WAIT_L(n) asm volatile("s_waitcnt lgkmcnt(" #n ")" ::: "memory")
#define PG8_WAIT_VF(fr) asm volatile("s_cmp_lg_u32 %0, 0\n\ts_cbranch_scc1 .Lpg8f%=\n\ts_waitcnt vmcnt(8)\n\ts_branch .Lpg8e%=\n.Lpg8f%=:\n\ts_waitcnt vmcnt(%1)\n.Lpg8e%=:" :: "s"(fr), "n"(8 + Epi::TAIL) : "memory", "scc")
#define PG8_BAR __builtin_amdgcn_s_barrier()
#define PG8_SCHED __builtin_amdgcn_sched_barrier(0)
    Unit cur, nxt; int ui = 0;
    if (!S.next(0, cur)) return;
    f32x4 acc[2][2][4][2];
#pragma unroll
    for (int a = 0; a < 2; ++a)
#pragma unroll
        for (int b = 0; b < 2; ++b)
#pragma unroll
            for (int m = 0; m < 4; ++m)
#pragma unroll
                for (int n = 0; n < 2; ++n) acc[a][b][m][n] = (f32x4){0.f, 0.f, 0.f, 0.f};
    bf16x8 At[4][2], B0[2][2], B1[2][2];
    const char* cA = S.a_ptr(cur); const char* cB = S.b_ptr(cur);
    S.a_ready(cur);
    if constexpr (SP2) {
        PG8_STAGE(PG8_SB(0, 0), cB, voffB); PG8_STAGE(PG8_SB(0, 1), cB + hB, voffB); PG8_STAGE(PG8_SA(0, 0), cA, voffA); PG8_STAGE(PG8_SA(0, 1), cA + hA, voffA);
        if (wr == 1) PG8_BAR;
        PG8_WAIT_V(2); PG8_BAR;
        PG8_STAGE(PG8_SB(1, 0), cB + kstep, voffB); PG8_STAGE(PG8_SA(1, 0), cA + kstep, voffA); PG8_STAGE(PG8_SB(1, 1), cB + hB + kstep, voffB);
        PG8_WAIT_V(6); PG8_BAR;
    } else {
        PG8_STAGE(PG8_SB(0, 0), cB, voffB); PG8_STAGE(PG8_SA(0, 0), cA, voffA); PG8_STAGE(PG8_SB(0, 1), cB + hB, voffB); PG8_STAGE(PG8_SA(0, 1), cA + hA, voffA);
        if (wr == 1) PG8_BAR;
        PG8_WAIT_V(4); PG8_BAR;
        PG8_STAGE(PG8_SB(1, 0), cB + kstep, voffB); PG8_STAGE(PG8_SA(1, 0), cA + kstep, voffA); PG8_STAGE(PG8_SB(1, 1), cB + hB + kstep, voffB);
        PG8_WAIT_V(6); PG8_BAR;
    }
    for (;;) {
        const bool has_next = S.next(ui + 1, nxt);
        const char* nA = has_next ? S.a_ptr(nxt) : cA; const char* nB = has_next ? S.b_ptr(nxt) : cB;
        for (int t = 0; t < nt; t += 2) {
            const bool last = (t == nt - 2);
            const char* a1 = cA + (size_t)(t + 1) * kstep;
            const char* a2 = last ? nA : cA + (size_t)(t + 2) * kstep; const char* b2 = last ? nB : cB + (size_t)(t + 2) * kstep;
            const char* a3 = a2 + kstep; const char* b3 = b2 + kstep;
            if (last && has_next) S.a_ready(nxt);
            if constexpr (SP2) {
            const int fresh = __builtin_amdgcn_readfirstlane(((Epi::TAIL > 0) && (ui > 0) && (t == 0)) ? 1 : 0);
            PG8_LDB(B0, 0, 0); PG8_LDB(B1, 0, 1); PG8_SCHED; PG8_LDA(At, 0, 0); PG8_STAGE(PG8_SA(1, 1), a1 + hA, voffA);
            if constexpr (Epi::TAIL > 0) PG8_WAIT_VF(fresh); else PG8_WAIT_V(8);
            PG8_WAIT_L(0); PG8_BAR; PG8_MMA(0, 0, At, B0); PG8_MMA(0, 1, At, B1); PG8_BAR; PG8_SCHED;
            PG8_LDA(At, 0, 1); PG8_STAGE(PG8_SB(0, 0), b2, voffB); PG8_STAGE(PG8_SB(0, 1), b2 + hB, voffB); PG8_STAGE(PG8_SA(0, 0), a2, voffA);
            if constexpr (Epi::TAIL > 0) PG8_WAIT_VF(fresh); else PG8_WAIT_V(8);
            PG8_WAIT_L(0); PG8_BAR; PG8_MMA(1, 0, At, B0); PG8_MMA(1, 1, At, B1); PG8_BAR; PG8_SCHED;
            PG8_LDB(B0, 1, 0); PG8_LDB(B1, 1, 1); PG8_SCHED; PG8_LDA(At, 1, 0); PG8_STAGE(PG8_SA(0, 1), a2 + hA, voffA);
            PG8_WAIT_V(8); PG8_WAIT_L(0); PG8_BAR; PG8_MMA(0, 0, At, B0); PG8_MMA(0, 1, At, B1); PG8_BAR; PG8_SCHED;
            PG8_LDA(At, 1, 1); PG8_STAGE(PG8_SB(1, 0), b3, voffB); PG8_STAGE(PG8_SB(1, 1), b3 + hB, voffB); PG8_STAGE(PG8_SA(1, 0), a3, voffA);
            PG8_WAIT_V(8); PG8_WAIT_L(0); PG8_BAR; PG8_MMA(1, 0, At, B0); PG8_MMA(1, 1, At, B1); PG8_BAR; PG8_SCHED;
            } else {
            PG8_LDB(B0, 0, 0); PG8_SCHED; PG8_LDA(At, 0, 0); PG8_STAGE(PG8_SA(1, 1), a1 + hA, voffA);
            PG8_WAIT_L(8); PG8_BAR; PG8_WAIT_L(0); PG8_MMA(0, 0, At, B0); PG8_BAR; PG8_SCHED;
            PG8_LDB(B1, 0, 1); PG8_STAGE(PG8_SB(0, 0), b2, voffB);
            PG8_BAR; PG8_WAIT_L(0); PG8_MMA(0, 1, At, B1); PG8_BAR;
            PG8_LDA(At, 0, 1); PG8_STAGE(PG8_SA(0, 0), a2, voffA);
            PG8_BAR; PG8_WAIT_L(0); PG8_MMA(1, 0, At, B0); PG8_BAR; PG8_SCHED;
            PG8_STAGE(PG8_SB(0, 1), b2 + hB, voffB);
            PG8_WAIT_V(6); PG8_BAR; PG8_MMA(1, 1, At, B1); PG8_BAR;
            PG8_LDB(B0, 1, 0); PG8_SCHED; PG8_LDA(At, 1, 0); PG8_STAGE(PG8_SA(0, 1), a2 + hA, voffA);
            PG8_WAIT_L(8); PG8_BAR; PG8_WAIT_L(0); PG8_MMA(0, 0, At, B0); PG8_BAR; PG8_SCHED;
            PG8_LDB(B1, 1, 1); PG8_STAGE(PG8_SB(1, 0), b3, voffB);
            PG8_BAR; PG8_WAIT_L(0); PG8_MMA(0, 1, At, B1); PG8_BAR;
            PG8_LDA(At, 1, 1); PG8_STAGE(PG8_SA(1, 0), a3, voffA);
            PG8_BAR; PG8_WAIT_L(0); PG8_MMA(1, 0, At, B0); PG8_BAR; PG8_SCHED;
            PG8_STAGE(PG8_SB(1, 1), b3 + hB, voffB);
            PG8_WAIT_V(6); PG8_BAR; PG8_MMA(1, 1, At, B1); PG8_BAR;
            }
        }
        if constexpr (ALIGN_EPI) { if (wr == 0) PG8_BAR; }
        if constexpr (!Epi::AFTER_DRAIN) { int fr_e = fr, fq_e = fq; asm volatile("" : "+v"(fr_e), "+v"(fq_e));
          E(acc, cur, wr, wc, fr_e, fq_e); } S.done(cur);
        if (!has_next) break;
#pragma unroll
        for (int a = 0; a < 2; ++a)
#pragma unroll
            for (int b = 0; b < 2; ++b)
#pragma unroll
                for (int m = 0; m < 4; ++m)
#pragma unroll
                    for (int n = 0; n < 2; ++n) acc[a][b][m][n] = (f32x4){0.f, 0.f, 0.f, 0.f};
        cur = nxt; cA = nA; cB = nB; ++ui;
        if constexpr (ALIGN_EPI) { if (wr == 1) PG8_BAR; }
    }
    PG8_WAIT_V(0);
    if constexpr (!ALIGN_EPI) { if (wr == 0) PG8_BAR; }
    PG8_BAR;
    if constexpr (Epi::AFTER_DRAIN) { int fr_e = fr, fq_e = fq; asm volatile("" : "+v"(fr_e), "+v"(fq_e));
        E.fused(acc, cur, wr, wc, fr_e, fq_e, lds, wid); }
#undef PG8_SA
#undef PG8_SB
#undef PG8_STAGE
#undef PG8_LDA
#undef PG8_LDB
#undef PG8_MMA
#undef PG8_WAIT_V
#undef PG8_WAIT_L
#undef PG8_WAIT_VF
#undef PG8_BAR
#undef PG8_SCHED
}
}

using pg8::bf16_t; using pg8::f32x4; using pg8::f32x2; using pg8::u32x4; using pg8::u32x2; using pg8::Unit;
constexpr int BATCH = 8, SEQ = 4096, D = 1024, M = BATCH * SEQ, FF = 4096, DEPTH = 4;
#ifndef MK_NTEAM
#define MK_NTEAM 1
#endif
constexpr int NTEAM = MK_NTEAM;
constexpr int MT = M / NTEAM;
constexpr int PT = MT / 256, PQ = MT / 256;
constexpr int MQ = MT;
constexpr int RIN = 6144, VD = 2048;
constexpr float RMS_EPS = 1e-6f, LN_EPS = 1e-5f;
#define L2G0 (-0.04580368961312479f)
#define L2G1 (-0.02272007650008353f)
#define L2G2 (-0.011315313227834146f)
#define L2G3 (-0.005646563141142063f)
__device__ __forceinline__ float l2gamma(int h) { return h == 0 ? L2G0 : (h == 1 ? L2G1 : (h == 2 ? L2G2 : L2G3)); }

__device__ __forceinline__ float shfl_x(float v, int o, int lane) { return __int_as_float(__builtin_amdgcn_ds_bpermute((lane ^ o) << 2, __float_as_int(v))); }
template <int CTRL> __device__ __forceinline__ float dpp_add(float x) { return x + __int_as_float(__builtin_amdgcn_update_dpp(0, __float_as_int(x), CTRL, 0xf, 0xf, true)); }
__device__ __forceinline__ float row16_sum(float x) { x = dpp_add<0xB1>(x); x = dpp_add<0x4E>(x); x = dpp_add<0x141>(x); x = dpp_add<0x140>(x); return x; }
__device__ __forceinline__ float wave_sum_u(float x) { x = row16_sum(x);
    return (__int_as_float(__builtin_amdgcn_readlane(__float_as_int(x), 0)) + __int_as_float(__builtin_amdgcn_readlane(__float_as_int(x), 16)))
         + (__int_as_float(__builtin_amdgcn_readlane(__float_as_int(x), 32)) + __int_as_float(__builtin_amdgcn_readlane(__float_as_int(x), 48))); }
__device__ __forceinline__ float wave_sum(float v, int lane) {
#pragma unroll
    for (int o = 1; o < 64; o <<= 1) v += shfl_x(v, o, lane);
    return v;
}
constexpr size_t MiB = 1u << 20;
constexpr size_t WS_CTL = 0, CTL_ZERO_BYTES = 2 * MiB;
constexpr size_t WS_XS = 1 * MiB;
constexpr size_t WS_SQ0 = 2 * MiB + 512 * 1024;
constexpr size_t WS_SQ = 3 * MiB;
constexpr size_t WS_GST = 8 * MiB;
constexpr size_t WS_W = 16 * MiB;
constexpr size_t WS_ROT = 48 * MiB;
constexpr size_t WS_XB = 64 * MiB;
constexpr size_t WS_R = 128 * MiB;
constexpr size_t WS_END = 512 * MiB;
constexpr int CW_BAR = 4096;
constexpr int CW_TMO = 0;
constexpr int CW_SEAM = 16384;

constexpr int RING_BYTES = 131072;
constexpr int LDSCTL_OFF = RING_BYTES, MISC_OFF = LDSCTL_OFF + 320;
constexpr int LDS_BYTES = 147456;
constexpr int NWAVES = 8;

#define GAS __attribute__((address_space(1)))
#define LAS __attribute__((address_space(3)))
typedef GAS unsigned gu32;

#define XB_TMO      128
#define XB_XCNT(j)  (256  + 64 * (j))
#define XB_XSUB(j)  (1280 + 64 * (j))
#define XB_XGEN(j)  (2304 + 64 * (j))
#define XB_TOP      3328
#define XB_TOPGEN   3392
#define XCD_BAR_WORDS 3456
#define XB_SPIN_CAP (1u << 18)
__device__ __forceinline__ unsigned xb_ld(unsigned* p)              { return __hip_atomic_load(p, __ATOMIC_RELAXED, __HIP_MEMORY_SCOPE_AGENT); }
__device__ __forceinline__ unsigned xb_add(unsigned* p, unsigned v) { return __hip_atomic_fetch_add(p, v, __ATOMIC_RELAXED, __HIP_MEMORY_SCOPE_AGENT); }
__device__ __forceinline__ unsigned xb_xcc_id() { return (unsigned)__builtin_amdgcn_s_getreg((3 << 11) | 20) & 0xFu; }
#define XB_SPIN(cond, bar) do { unsigned _sp = 0; while (cond) { __builtin_amdgcn_s_sleep(1); \
    if ((++_sp & 255u) == 0u) { if (xb_ld(&(bar)[XB_TMO])) break; if (_sp > XB_SPIN_CAP) { atomicAdd(&(bar)[XB_TMO], 1u); break; } } } } while (0)
struct XcdBarrier { unsigned* bar; unsigned x; volatile LAS unsigned* st; unsigned gexp; };
__device__ __forceinline__ XcdBarrier xcd_barrier_post(unsigned* bar, volatile LAS unsigned* st, unsigned gexp) {
    XcdBarrier b; b.bar = bar; b.x = xb_xcc_id(); b.st = st; b.gexp = gexp;
    if (threadIdx.x == 0) (void)xb_add(&bar[XB_XCNT(b.x)], 1u);
    return b;
}
__device__ __forceinline__ void xcd_barrier_complete(unsigned* bar, unsigned x, unsigned G, unsigned& nloc, unsigned& nx) {
    unsigned sum, cnt, mine, sp = 0u;
    for (;;) {
        sum = 0u; cnt = 0u; mine = 0u;
#pragma unroll
        for (unsigned j = 0; j < 16; ++j) { const unsigned c = xb_ld(&bar[XB_XCNT(j)]); sum += c; cnt += (c > 0u) ? 1u : 0u; mine = (j == x) ? c : mine; }
        if (sum == G) break;
        __builtin_amdgcn_s_sleep(1);
        if ((++sp & 255u) == 0u) { if (xb_ld(&bar[XB_TMO])) break; if (sp > XB_SPIN_CAP) { atomicAdd(&bar[XB_TMO], 1u); break; } }
    }
    nloc = mine > 0u ? mine : 1u; nx = cnt > 0u ? cnt : 1u;
}
__device__ __forceinline__ void xcd_barrier(const XcdBarrier& b) {
    asm volatile("s_waitcnt vmcnt(0)" ::: "memory");
    __syncthreads();
    if (threadIdx.x == 0) {
        unsigned* bar = b.bar;
        __builtin_amdgcn_s_waitcnt(0);
        unsigned nloc = b.st[0], nx = b.st[1];
        if (nloc == 0u) { xcd_barrier_complete(bar, b.x, b.gexp, nloc, nx); b.st[0] = nloc; b.st[1] = nx; }
        const unsigned old = xb_add(&bar[XB_XSUB(b.x)], 1u);
        const unsigned gen = old / nloc;
        if (old + 1u == (gen + 1u) * nloc) {
            __builtin_amdgcn_fence(__ATOMIC_RELEASE, "agent");
            asm volatile("s_waitcnt vmcnt(0)" ::: "memory");
            const unsigned og = xb_add(&bar[XB_TOP], 1u);
            const unsigned tg = og / nx;
            if (og + 1u == (tg + 1u) * nx) xb_add(&bar[XB_TOPGEN], 1u);
            else XB_SPIN(xb_ld(&bar[XB_TOPGEN]) == tg, bar);
            __builtin_amdgcn_fence(__ATOMIC_ACQUIRE, "agent");
            xb_add(&bar[XB_XGEN(b.x)], 1u);
            asm volatile("s_waitcnt vmcnt(0)" ::: "memory");
        } else {
            XB_SPIN(xb_ld(&bar[XB_XGEN(b.x)]) == gen, bar);
            __builtin_amdgcn_fence(__ATOMIC_ACQUIRE, "agent");
            asm volatile("s_waitcnt vmcnt(0)" ::: "memory");
        }
    }
    __syncthreads();
}

template <class Base> struct SchedStdT : Base {
    const char* A; const char* B; size_t sa, sb;
    __device__ __forceinline__ const char* a_ptr(const Unit& u) const { return A + (size_t)u.pm * sa; }
    __device__ __forceinline__ const char* b_ptr(const Unit& u) const { return B + (size_t)u.pn * sb; }
};
typedef SchedStdT<pg8::Ord> SchedStd; typedef SchedStdT<pg8::OrdPanel> SchedRnd;
struct SchedP1 {
    pg8::Ord o0, o1; int n0;
    const char* X; const char* W;
    __device__ __forceinline__ bool next(int i, Unit& u) const { if (i < n0) return o0.next(i, u); const bool ok = o1.next(i - n0, u); u.kind = 1; return ok; }
    __device__ __forceinline__ const char* a_ptr(const Unit& u) const { return u.kind ? W + ((size_t)2048 + (size_t)u.pm * 256) * D * 2 : X + (size_t)u.pm * 256 * D * 2; }
    __device__ __forceinline__ const char* b_ptr(const Unit& u) const { return u.kind ? X + (size_t)u.pn * 256 * D * 2 : W + (size_t)u.pn * 256 * D * 2; }
    __device__ __forceinline__ void a_ready(const Unit&) const {}
    __device__ __forceinline__ void done(const Unit&) const {}
};
struct SchedR1 : pg8::Ord {
    const char* QP; const char* KK;
    __device__ __forceinline__ const char* a_ptr(const Unit& u) const { return QP + ((size_t)u.pm * 256 * 2048 + (size_t)u.pn * 512 + 256) * 2; }
    __device__ __forceinline__ const char* b_ptr(const Unit& u) const { return KK + ((size_t)u.pm * 256 * 1024 + (size_t)u.pn * 256) * 2; }
};
struct SchedR2 : pg8::Ord {
    const char* BC; const char* KT;
    __device__ __forceinline__ const char* a_ptr(const Unit& u) const { return BC + ((size_t)u.pm * 4 * 512 * 512 + (size_t)u.pn * 256 * 512) * 2; }
    __device__ __forceinline__ const char* b_ptr(const Unit& u) const { return KT + ((size_t)(u.pn >> 1) * 256 * MQ + (size_t)u.pm * 256) * 2; }
};
struct SchedR4 : pg8::Ord {
    const char* QP; const char* BC;
    __device__ __forceinline__ const char* a_ptr(const Unit& u) const { return QP + ((size_t)u.pm * 256 * 2048 + (size_t)(u.pn >> 1) * 512) * 2; }
    __device__ __forceinline__ const char* b_ptr(const Unit& u) const { return BC + ((size_t)u.pm * 4 * 512 * 512 + (size_t)u.pn * 256 * 512) * 2; }
};

__device__ __forceinline__ float row_scale(const float* ssq2, size_t row) { const f32x4 q = *(const f32x4*)(ssq2 + row * 4); return __builtin_amdgcn_rsqf(((q[0] + q[1]) + (q[2] + q[3])) * (1.0f / 1024.0f) + RMS_EPS); }

struct EpiRelu2 {
    static constexpr bool PERM = true, AFTER_DRAIN = false; static constexpr int TAIL = 16;
    bf16_t* O; int ldc;
    __device__ __forceinline__ void operator()(const f32x4 (&acc)[2][2][4][2], const Unit& u, int wr, int wc, int fr, int fq) const {
        const int row0 = u.pm * 256 + wr * 64 + fr, col0 = u.pn * 256 + wc * 32 + 8 * fq;
#pragma unroll
        for (int ai = 0; ai < 2; ++ai)
#pragma unroll
            for (int m = 0; m < 4; ++m) { bf16_t* rowp = O + (size_t)(row0 + ai * 128 + m * 16) * ldc + col0;
#pragma unroll
                for (int bj = 0; bj < 2; ++bj) { f32x4 v0 = acc[ai][bj][m][0], v1 = acc[ai][bj][m][1];
#pragma unroll
                    for (int j = 0; j < 4; ++j) { const float a = fmaxf(v0[j], 0.f), b = fmaxf(v1[j], 0.f); v0[j] = a * a; v1[j] = b * b; }
                    *(u32x4*)(rowp + bj * 128) = pg8::pack8(v0, v1); } }
    }
};
struct EpiGLU {
    static constexpr bool PERM = true, AFTER_DRAIN = false; static constexpr int TAIL = 0;
    bf16_t* O; const float* bias; const float* ssq2;
    __device__ __forceinline__ void operator()(const f32x4 (&acc)[2][2][4][2], const Unit& u, int wr, int wc, int fr, int fq) const {
        const int row0 = u.pm * 256 + wr * 64 + fr, col = u.pn * 128 + wc * 32 + 8 * fq;
        f32x4 ba[2], bg[2];
#pragma unroll
        for (int n = 0; n < 2; ++n) { ba[n] = *(const f32x4*)(bias + col + 4 * n); bg[n] = *(const f32x4*)(bias + 1024 + col + 4 * n); }
        float sc[2][4];
#pragma unroll
        for (int ai = 0; ai < 2; ++ai)
#pragma unroll
            for (int m = 0; m < 4; ++m) sc[ai][m] = row_scale(ssq2, (size_t)(row0 + ai * 128 + m * 16));
#pragma unroll
        for (int ai = 0; ai < 2; ++ai)
#pragma unroll
            for (int m = 0; m < 4; ++m) { bf16_t* rowp = O + (size_t)(row0 + ai * 128 + m * 16) * 1024 + col;
                f32x4 v[2];
#pragma unroll
                for (int n = 0; n < 2; ++n) { const f32x4 a = acc[ai][0][m][n] * sc[ai][m] + ba[n], g = acc[ai][1][m][n] * sc[ai][m] + bg[n];
#pragma unroll
                    for (int j = 0; j < 4; ++j) v[n][j] = a[j] * pg8::fast_sigmoid(g[j]); }
                *(u32x4*)rowp = pg8::pack8(v[0], v[1]); }
    }
};
struct EpiSC {
    static constexpr bool PERM = true, AFTER_DRAIN = false; static constexpr int TAIL = 0;
    bf16_t* GB; bf16_t* GCH; const float* ssq2;
    __device__ __forceinline__ void operator()(const f32x4 (&acc)[2][2][4][2], const Unit& u, int wr, int wc, int fr, int fq) const {
        const int row0 = u.pm * 256 + wr * 64 + fr;
        float sc[2][4];
#pragma unroll
        for (int ai = 0; ai < 2; ++ai)
#pragma unroll
            for (int m = 0; m < 4; ++m) sc[ai][m] = row_scale(ssq2, (size_t)(row0 + ai * 128 + m * 16));
        if (u.pn < 4) {
            const int col0 = u.pn * 256 + wc * 32 + 8 * fq;
#pragma unroll
            for (int ai = 0; ai < 2; ++ai)
#pragma unroll
                for (int m = 0; m < 4; ++m) { bf16_t* rowp = GB + (size_t)(row0 + ai * 128 + m * 16) * 1024 + col0;
#pragma unroll
                    for (int bj = 0; bj < 2; ++bj) *(u32x4*)(rowp + bj * 128) = pg8::pack8(acc[ai][bj][m][0] * sc[ai][m], acc[ai][bj][m][1] * sc[ai][m]); }
        } else {
            const int col = (u.pn - 4) * 128 + wc * 32 + 8 * fq;
#pragma unroll
            for (int ai = 0; ai < 2; ++ai)
#pragma unroll
                for (int m = 0; m < 4; ++m) { bf16_t* rowp = GCH + (size_t)(row0 + ai * 128 + m * 16) * 1024 + col;
                    const float s2 = sc[ai][m] * sc[ai][m]; *(u32x4*)rowp = pg8::pack8(acc[ai][0][m][0] * acc[ai][1][m][0] * s2, acc[ai][0][m][1] * acc[ai][1][m][1] * s2); }
        }
    }
};
struct EpiRetN {
    static constexpr bool PERM = true, AFTER_DRAIN = false; static constexpr int TAIL = 0;
    bf16_t* QP; bf16_t* KK; bf16_t* KT; const unsigned* ROT; const float* ssq2;
    LAS bf16_t* trb;
    __device__ __forceinline__ void operator()(const f32x4 (&acc)[2][2][4][2], const Unit& u, int wr, int wc, int fr, int fq) const {
        const int h = u.pn & 3; const bool isk = u.pn >= 4;
        const float l2g = isk ? l2gamma(h) : 0.f, scb = isk ? 0.0625f : 1.0f;
        bf16_t* base = isk ? (KK + h * 256) : (QP + h * 512 + 256); const int pitch = isk ? 1024 : 2048;
        const int f0 = wc * 32 + 8 * fq;
#pragma unroll
        for (int ai = 0; ai < 2; ++ai) {
            u32x4 t[4][2]; float s2r[4];
#pragma unroll
            for (int m = 0; m < 4; ++m) { const size_t ml = (size_t)u.pm * 256 + ai * 128 + wr * 64 + m * 16 + fr; const u32x4* rt = (const u32x4*)(ROT + ml * 128 + f0);
                t[m][0] = rt[0]; t[m][1] = rt[1];
                s2r[m] = row_scale(ssq2, ml); }
#pragma unroll
            for (int m = 0; m < 4; ++m) {
                const int r = ai * 128 + wr * 64 + m * 16 + fr; const size_t ml = (size_t)u.pm * 256 + r;
                const unsigned tw[8] = {t[m][0].x, t[m][0].y, t[m][0].z, t[m][0].w, t[m][1].x, t[m][1].y, t[m][1].z, t[m][1].w};
                float cs[8], sn[8];
#pragma unroll
                for (int e = 0; e < 8; ++e) { cs[e] = pg8::bf_lo(tw[e]); sn[e] = pg8::bf_hi(tw[e]); }
                const float sc = scb * __builtin_amdgcn_exp2f(-(float)(r + 1) * l2g) * (isk ? s2r[m] * s2r[m] : s2r[m]);
                f32x4 o1[2], o2[2];
#pragma unroll
                for (int n = 0; n < 2; ++n)
#pragma unroll
                    for (int j = 0; j < 4; ++j) { const float x1 = acc[ai][0][m][n][j], x2 = acc[ai][1][m][n][j], c = cs[4 * n + j], s = sn[4 * n + j];
                        o1[n][j] = (x1 * c - x2 * s) * sc; o2[n][j] = (x2 * c + x1 * s) * sc; }
                const u32x4 w1 = pg8::pack8(o1[0], o1[1]), w2 = pg8::pack8(o2[0], o2[1]);
                bf16_t* dst = base + ml * pitch + f0;
                *(u32x4*)dst = w1; *(u32x4*)(dst + 128) = w2;
                if (isk) {
                    LAS bf16_t* tb = trb + (wr * 4 + wc) * 512;
                    const int ln = fr | (fq << 4), dl = ln >> 1, th = ln & 1;
                    bf16_t* kt = KT + (size_t)(h * 256 + wc * 32 + dl) * MQ + ((size_t)u.pm * 256 + ai * 128 + wr * 64 + m * 16 + th * 8);
#pragma unroll
                    for (int half = 0; half < 2; ++half) {
                        const u32x4 w = half ? w2 : w1; const unsigned a[4] = {w.x, w.y, w.z, w.w};
#pragma unroll
                        for (int e = 0; e < 4; ++e) { tb[(8 * fq + 2 * e) * 16 + fr] = (bf16_t)(a[e] & 0xffffu); tb[(8 * fq + 2 * e + 1) * 16 + fr] = (bf16_t)(a[e] >> 16); }
                        asm volatile("s_waitcnt lgkmcnt(0)" ::: "memory");
                        const u32x4 tv = *(const LAS u32x4*)(tb + dl * 16 + th * 8);
                        asm volatile("s_waitcnt lgkmcnt(0)" ::: "memory");
                        *(u32x4*)(kt + (size_t)half * 128 * MQ) = tv;
                    }
                }
            }
        }
    }
};
struct EpiRetT {
    static constexpr bool PERM = true, AFTER_DRAIN = false; static constexpr int TAIL = 0;
    bf16_t* BC;
    __device__ __forceinline__ void operator()(const f32x4 (&acc)[2][2][4][2], const Unit& u, int wr, int wc, int fr, int fq) const {
        const int pv = u.pm, pt = u.pn, h = pv >> 1, dvb = (pv & 1) * 256; const int c0 = wc * 32 + 8 * fq;
#pragma unroll
        for (int ai = 0; ai < 2; ++ai)
#pragma unroll
            for (int m = 0; m < 4; ++m) { const int dv = dvb + ai * 128 + wr * 64 + m * 16 + fr;
                bf16_t* rowp = BC + ((size_t)(pt * 4 + h) * 512 + dv) * 512 + c0;
#pragma unroll
                for (int bj = 0; bj < 2; ++bj) *(u32x4*)(rowp + bj * 128) = pg8::pack8(acc[ai][bj][m][0], acc[ai][bj][m][1]); }
    }
};
struct EpiP1 {
    static constexpr bool PERM = true, AFTER_DRAIN = false; static constexpr int TAIL = 0;
    EpiRetN n; EpiRetT t;
    __device__ __forceinline__ void operator()(const f32x4 (&acc)[2][2][4][2], const Unit& u, int wr, int wc, int fr, int fq) const { if (u.kind) t(acc, u, wr, wc, fr, fq); else n(acc, u, wr, wc, fr, fq); }
};
struct EpiS {
    static constexpr bool PERM = true, AFTER_DRAIN = false; static constexpr int TAIL = 0;
    bf16_t* QP;
    __device__ __forceinline__ void operator()(const f32x4 (&acc)[2][2][4][2], const Unit& u, int wr, int wc, int fr, int fq) const {
        const int h = u.pn;
#pragma unroll
        for (int ai = 0; ai < 2; ++ai)
#pragma unroll
            for (int m = 0; m < 4; ++m) { const int i = ai * 128 + wr * 64 + m * 16 + fr;
                bf16_t* rowp = QP + ((size_t)u.pm * 256 + i) * 2048 + h * 512;
#pragma unroll
                for (int bj = 0; bj < 2; ++bj) { const int j0 = bj * 128 + wc * 32 + 8 * fq; f32x4 v0 = acc[ai][bj][m][0], v1 = acc[ai][bj][m][1];
#pragma unroll
                    for (int jj = 0; jj < 4; ++jj) {
                        v0[jj] = __uint_as_float(__float_as_uint(v0[jj]) & ~(unsigned)((i - (j0 + jj)) >> 31));
                        v1[jj] = __uint_as_float(__float_as_uint(v1[jj]) & ~(unsigned)((i - (j0 + 4 + jj)) >> 31)); }
                    *(u32x4*)(rowp + j0) = pg8::pack8(v0, v1); } }
    }
};
struct EpiKV {
    static constexpr bool PERM = true, AFTER_DRAIN = false; static constexpr int TAIL = 0;
    bf16_t* BC;
    __device__ __forceinline__ void operator()(const f32x4 (&acc)[2][2][4][2], const Unit& u, int wr, int wc, int fr, int fq) const {
        const int h = u.pn >> 1, t = u.pn & 1;
#pragma unroll
        for (int ai = 0; ai < 2; ++ai)
#pragma unroll
            for (int m = 0; m < 4; ++m) { const int r = ai * 128 + wr * 64 + m * 16 + fr;
                bf16_t* rowp = BC + ((size_t)(u.pm * 4 + h) * 512 + t * 256 + r) * 512 + 256 + wc * 32 + 8 * fq;
#pragma unroll
                for (int bj = 0; bj < 2; ++bj) *(u32x4*)(rowp + bj * 128) = pg8::pack8(acc[ai][bj][m][0], acc[ai][bj][m][1]); }
    }
};
struct EpiO {
    static constexpr bool PERM = true, AFTER_DRAIN = false; static constexpr int TAIL = 0;
    bf16_t* O; f32x2* GST; LAS f32x2* P;
    __device__ __forceinline__ void operator()(const f32x4 (&acc)[2][2][4][2], const Unit& u, int wr, int wc, int fr, int fq) const {
        const int h = u.pn >> 1, t = u.pn & 1; const float l2g = l2gamma(h); const int ln = fr | (fq << 4);
#pragma unroll
        for (int ai = 0; ai < 2; ++ai)
#pragma unroll
            for (int m = 0; m < 4; ++m) { const int i = ai * 128 + wr * 64 + m * 16 + fr; const size_t ml = (size_t)u.pm * 256 + i;
                const float sc = __builtin_amdgcn_exp2f((float)(i + 1) * l2g);
                bf16_t* rowp = O + ml * 2048 + h * 512 + t * 256 + wc * 32 + 8 * fq;
                float s1 = 0.f, s2 = 0.f;
#pragma unroll
                for (int bj = 0; bj < 2; ++bj) { const f32x4 v0 = acc[ai][bj][m][0] * sc, v1 = acc[ai][bj][m][1] * sc;
                    s1 += (v0[0] + v0[1]) + (v0[2] + v0[3]) + (v1[0] + v1[1]) + (v1[2] + v1[3]);
                    s2 += (v0[0] * v0[0] + v0[1] * v0[1]) + (v0[2] * v0[2] + v0[3] * v0[3]) + (v1[0] * v1[0] + v1[1] * v1[1]) + (v1[2] * v1[2] + v1[3] * v1[3]);
                    *(u32x4*)(rowp + bj * 128) = pg8::pack8(v0, v1); }
                s1 += shfl_x(s1, 16, ln); s1 += shfl_x(s1, 32, ln); s2 += shfl_x(s2, 16, ln); s2 += shfl_x(s2, 32, ln);
                if (fq == 0) P[i * 4 + wc] = (f32x2){s1, s2};
            }
        asm volatile("s_waitcnt lgkmcnt(0)" ::: "memory"); __builtin_amdgcn_s_barrier(); asm volatile("" ::: "memory");
        if (ln < 32) { const int row = (wr * 4 + wc) * 32 + ln; const LAS f32x4* pp = (const LAS f32x4*)(P + row * 4); const f32x4 a = pp[0], b = pp[1];
            GST[((size_t)u.pm * 256 + row) * 8 + h * 2 + t] = (f32x2){(a[0] + a[2]) + (b[0] + b[2]), (a[1] + a[3]) + (b[1] + b[3])}; }
        asm volatile("s_waitcnt lgkmcnt(0)" ::: "memory");
    }
};
struct EpiG {
    static constexpr bool PERM = true, AFTER_DRAIN = false; static constexpr int TAIL = 0;
    bf16_t* O; const f32x2* GST; const float* gng; const float* ssq2;
    __device__ __forceinline__ void operator()(const f32x4 (&acc)[2][2][4][2], const Unit& u, int wr, int wc, int fr, int fq) const {
        const int h = u.pn >> 1, colb = u.pn * 256 + wc * 32 + 8 * fq;
        f32x4 g[2][2];
#pragma unroll
        for (int bj = 0; bj < 2; ++bj)
#pragma unroll
            for (int n = 0; n < 2; ++n) g[bj][n] = *(const f32x4*)(gng + colb + bj * 128 + 4 * n);
        f32x4 st[2][2], sq[2][2]; u32x4 ow[2][2][2];
#define EPIG_LOAD(buf, b) do { _Pragma("unroll") for (int e = 0; e < 2; ++e) { const size_t ml_ = (size_t)u.pm * 256 + ((b) >> 1) * 128 + wr * 64 + (((b) & 1) * 2 + e) * 16 + fr; \
            st[buf][e] = *(const f32x4*)(GST + ml_ * 8 + h * 2); sq[buf][e] = *(const f32x4*)(ssq2 + ml_ * 4); \
            _Pragma("unroll") for (int bj = 0; bj < 2; ++bj) ow[buf][e][bj] = *(const u32x4*)(O + ml_ * 2048 + colb + bj * 128); } } while (0)
        EPIG_LOAD(0, 0);
#pragma unroll
        for (int b = 0; b < 4; ++b) {
            const int cb = b & 1, ai = b >> 1;
            if (b + 1 < 4) EPIG_LOAD(cb ^ 1, b + 1);
#pragma unroll
            for (int e = 0; e < 2; ++e) { const int m = (b & 1) * 2 + e; const size_t ml = (size_t)u.pm * 256 + ai * 128 + wr * 64 + m * 16 + fr; bf16_t* rowp = O + ml * 2048 + colb;
                const f32x4 s = st[cb][e], q = sq[cb][e];
                const float S1 = s[0] + s[2], S2 = s[1] + s[3];
                const float mean = S1 * (1.0f / 512.0f); const float var = fmaxf(S2 * (1.0f / 512.0f) - mean * mean, 0.f); const float rstd = __builtin_amdgcn_rsqf(var + LN_EPS);
                const float s2r = __builtin_amdgcn_rsqf(((q[0] + q[1]) + (q[2] + q[3])) * (1.0f / 1024.0f) + RMS_EPS);
#pragma unroll
                for (int bj = 0; bj < 2; ++bj) { const u32x4 w = ow[cb][e][bj];
                    const float o[8] = {pg8::bf_lo(w.x), pg8::bf_hi(w.x), pg8::bf_lo(w.y), pg8::bf_hi(w.y), pg8::bf_lo(w.z), pg8::bf_hi(w.z), pg8::bf_lo(w.w), pg8::bf_hi(w.w)};
                    f32x4 v[2];
#pragma unroll
                    for (int n = 0; n < 2; ++n)
#pragma unroll
                        for (int j = 0; j < 4; ++j) { const float a = acc[ai][bj][m][n][j] * s2r; v[n][j] = (o[4 * n + j] - mean) * rstd * g[bj][n][j] * (a * pg8::fast_sigmoid(a)); }
                    *(u32x4*)(rowp + bj * 128) = pg8::pack8(v[0], v[1]); } }
        }
#undef EPIG_LOAD
    }
};

struct EpiNorm {
    static constexpr bool PERM = true, AFTER_DRAIN = false; static constexpr int TAIL = 0;
    const bf16_t* xin; bf16_t* xout; float* fout; float* ssq2; const float* gpost; const float* bias;
    unsigned long long* xslot; unsigned epoch; unsigned* tmo;
    const float* sq_old;
    LAS unsigned char* tb;
    __device__ __forceinline__ void operator()(const f32x4 (&acc_in)[2][2][4][2], const Unit& u, int wr, int wc, int fr, int fq) const {
        LAS float* P = (LAS float*)tb;
        LAS float* S = (LAS float*)(tb + 4096);
        const int lane = fr | (fq << 4), wid = wr * 4 + wc;
        const int colb = u.pn * 256 + wc * 32 + 8 * fq;
        u32x4 xw[2][4][2];
#pragma unroll
        for (int ai = 0; ai < 2; ++ai)
#pragma unroll
            for (int m = 0; m < 4; ++m) { const size_t r = (size_t)u.pm * 256 + ai * 128 + wr * 64 + m * 16 + fr;
#pragma unroll
                for (int bj = 0; bj < 2; ++bj) xw[ai][m][bj] = *(const u32x4*)(xin + r * D + colb + bj * 128); }
        f32x4 acc[2][2][4][2];
        if (bias) {
#pragma unroll
            for (int bj = 0; bj < 2; ++bj)
#pragma unroll
                for (int n = 0; n < 2; ++n) { const f32x4 bv = *(const f32x4*)(bias + colb + bj * 128 + 4 * n);
#pragma unroll
                    for (int ai = 0; ai < 2; ++ai)
#pragma unroll
                        for (int m = 0; m < 4; ++m) acc[ai][bj][m][n] = acc_in[ai][bj][m][n] + bv; }
        } else {
#pragma unroll
            for (int bj = 0; bj < 2; ++bj)
#pragma unroll
                for (int n = 0; n < 2; ++n)
#pragma unroll
                    for (int ai = 0; ai < 2; ++ai)
#pragma unroll
                        for (int m = 0; m < 4; ++m) acc[ai][bj][m][n] = acc_in[ai][bj][m][n];
        }
#pragma unroll
        for (int ai = 0; ai < 2; ++ai)
#pragma unroll
            for (int m = 0; m < 4; ++m) { float s = 0.f;
#pragma unroll
                for (int bj = 0; bj < 2; ++bj)
#pragma unroll
                    for (int n = 0; n < 2; ++n) { const f32x4 x = acc[ai][bj][m][n]; s += (x[0] * x[0] + x[1] * x[1]) + (x[2] * x[2] + x[3] * x[3]); }
                s += shfl_x(s, 16, lane); s += shfl_x(s, 32, lane);
                if (fq == 0) P[(ai * 128 + wr * 64 + m * 16 + fr) * 4 + wc] = s; }
        asm volatile("s_waitcnt lgkmcnt(0)" ::: "memory"); __builtin_amdgcn_s_barrier(); asm volatile("" ::: "memory");
        const int row = wid * 32 + (lane & 31);
        float eps_eff = RMS_EPS;
        if (sq_old && lane < 32) { const f32x4 q = *(const f32x4*)(sq_old + ((size_t)u.pm * 256 + row) * 4); const float is2 = ((q[0] + q[1]) + (q[2] + q[3])) * (1.0f / 1024.0f) + RMS_EPS; eps_eff = RMS_EPS * is2 * is2; }
        unsigned long long* sl = xslot + ((size_t)u.pm * 256 + row) * 4;
        if (lane < 32) { const f32x4 p = *(const LAS f32x4*)(P + row * 4);
            __hip_atomic_store(sl + u.pn, ((unsigned long long)epoch << 32) | (unsigned long long)__float_as_uint((p[0] + p[1]) + (p[2] + p[3])), __ATOMIC_RELAXED, __HIP_MEMORY_SCOPE_AGENT); }
        { float t = 0.f; unsigned spins = 0;
          for (;;) { bool ok = true; t = 0.f;
              if (lane < 32) {
#pragma unroll
                  for (int q = 0; q < 4; ++q) { const unsigned long long x = __hip_atomic_load(sl + q, __ATOMIC_RELAXED, __HIP_MEMORY_SCOPE_AGENT); ok &= ((unsigned)(x >> 32) == epoch); t += __uint_as_float((unsigned)x); } }
              if (__all(ok)) break;
              if ((++spins & 63u) == 0u) { if (__builtin_amdgcn_readfirstlane(__hip_atomic_load(tmo, __ATOMIC_RELAXED, __HIP_MEMORY_SCOPE_AGENT)) != 0u) break;
                  if (spins > (1u << 16)) { if (lane == 0) __hip_atomic_store(tmo, 1u, __ATOMIC_RELAXED, __HIP_MEMORY_SCOPE_AGENT); break; } }
              __builtin_amdgcn_s_sleep(1);
          }
          if (lane < 32) S[row] = __builtin_amdgcn_rsqf(t * (1.0f / 1024.0f) + eps_eff); }
        asm volatile("s_waitcnt vmcnt(0) lgkmcnt(0)" ::: "memory"); __builtin_amdgcn_s_barrier(); asm volatile("" ::: "memory");
        f32x4 gp[2][2];
#pragma unroll
        for (int bj = 0; bj < 2; ++bj)
#pragma unroll
            for (int n = 0; n < 2; ++n) gp[bj][n] = *(const f32x4*)(gpost + colb + bj * 128 + 4 * n);
#pragma unroll
        for (int ai = 0; ai < 2; ++ai) {
#pragma unroll
            for (int m = 0; m < 4; ++m) { const int rl = ai * 128 + wr * 64 + m * 16 + fr; const size_t r = (size_t)u.pm * 256 + rl; const float s1 = S[rl]; float q = 0.f;
#pragma unroll
                for (int bj = 0; bj < 2; ++bj) { const u32x4 w = xw[ai][m][bj];
                    f32x4 x0 = (f32x4){pg8::bf_lo(w.x), pg8::bf_hi(w.x), pg8::bf_lo(w.y), pg8::bf_hi(w.y)}, x1 = (f32x4){pg8::bf_lo(w.z), pg8::bf_hi(w.z), pg8::bf_lo(w.w), pg8::bf_hi(w.w)};
                    x0 += acc[ai][bj][m][0] * s1 * gp[bj][0]; x1 += acc[ai][bj][m][1] * s1 * gp[bj][1];
                    if (fout) { float* op = fout + r * D + colb + bj * 128; *(f32x4*)op = x0; *(f32x4*)(op + 4) = x1; }
                    else { const u32x4 xo = pg8::pack8(x0, x1); *(u32x4*)(xout + r * D + colb + bj * 128) = xo;
                        x0 = (f32x4){pg8::bf_lo(xo.x), pg8::bf_hi(xo.x), pg8::bf_lo(xo.y), pg8::bf_hi(xo.y)}; x1 = (f32x4){pg8::bf_lo(xo.z), pg8::bf_hi(xo.z), pg8::bf_lo(xo.w), pg8::bf_hi(xo.w)};
                        q += (x0[0] * x0[0] + x0[1] * x0[1]) + (x0[2] * x0[2] + x0[3] * x0[3]) + (x1[0] * x1[0] + x1[1] * x1[1]) + (x1[2] * x1[2] + x1[3] * x1[3]);
                    } }
                q += shfl_x(q, 16, lane); q += shfl_x(q, 32, lane);
                if (fq == 0) P[rl * 4 + wc] = q; }
        }
        asm volatile("s_waitcnt lgkmcnt(0)" ::: "memory"); __builtin_amdgcn_s_barrier(); asm volatile("" ::: "memory");
        if (!fout && lane < 32) { const f32x4 p = *(const LAS f32x4*)(P + row * 4); ssq2[((size_t)u.pm * 256 + row) * 4 + u.pn] = (p[0] + p[1]) + (p[2] + p[3]); }
        asm volatile("s_waitcnt lgkmcnt(0)" ::: "memory");
    }
};
template <bool HAS_Y, bool HAS_A, bool XIN_F32, bool XOUT_F32>
__device__ __forceinline__ void thin_norm(const bf16_t* y, const void* xin, void* xout, const float* gpost, const float* gpre, bf16_t* aout, int gw, int NGW, int lane) {
    f32x4 gp[4], gq[4];
#pragma unroll
    for (int j = 0; j < 4; ++j) { gp[j] = HAS_Y ? *(const f32x4*)(gpost + 4 * lane + 256 * j) : (f32x4){0.f, 0.f, 0.f, 0.f}; gq[j] = HAS_A ? *(const f32x4*)(gpre + 4 * lane + 256 * j) : (f32x4){0.f, 0.f, 0.f, 0.f}; }
    for (int m = gw; m < M; m += NGW) {
        f32x4 xv[4];
#pragma unroll
        for (int j = 0; j < 4; ++j) {
            if constexpr (XIN_F32) xv[j] = *(const f32x4*)((const float*)xin + (size_t)m * D + 4 * lane + 256 * j);
            else { const u32x2 w = *(const u32x2*)((const bf16_t*)xin + (size_t)m * D + 4 * lane + 256 * j); xv[j] = (f32x4){pg8::bf_lo(w.x), pg8::bf_hi(w.x), pg8::bf_lo(w.y), pg8::bf_hi(w.y)}; } }
        if constexpr (HAS_Y) {
            f32x4 yv[4]; float ss = 0.f;
#pragma unroll
            for (int j = 0; j < 4; ++j) { const u32x2 w = *(const u32x2*)(y + (size_t)m * D + 4 * lane + 256 * j);
                yv[j] = (f32x4){pg8::bf_lo(w.x), pg8::bf_hi(w.x), pg8::bf_lo(w.y), pg8::bf_hi(w.y)};
                ss += (yv[j][0] * yv[j][0] + yv[j][1] * yv[j][1]) + (yv[j][2] * yv[j][2] + yv[j][3] * yv[j][3]); }
            const float s1 = 1.0f / sqrtf(wave_sum(ss, lane) * (1.0f / D) + RMS_EPS);
#pragma unroll
            for (int j = 0; j < 4; ++j) xv[j] += yv[j] * s1 * gp[j];
#pragma unroll
            for (int j = 0; j < 4; ++j) {
                if constexpr (XOUT_F32) *(f32x4*)((float*)xout + (size_t)m * D + 4 * lane + 256 * j) = xv[j];
                else { u32x2 w; w.x = pg8::cvt_pk_bf16(xv[j][0], xv[j][1]); w.y = pg8::cvt_pk_bf16(xv[j][2], xv[j][3]); *(u32x2*)((bf16_t*)xout + (size_t)m * D + 4 * lane + 256 * j) = w;
                       xv[j] = (f32x4){pg8::bf_lo(w.x), pg8::bf_hi(w.x), pg8::bf_lo(w.y), pg8::bf_hi(w.y)}; } }
        }
        if constexpr (HAS_A) {
            float ss = 0.f;
#pragma unroll
            for (int j = 0; j < 4; ++j) ss += (xv[j][0] * xv[j][0] + xv[j][1] * xv[j][1]) + (xv[j][2] * xv[j][2] + xv[j][3] * xv[j][3]);
            const float s2 = 1.0f / sqrtf(wave_sum(ss, lane) * (1.0f / D) + RMS_EPS);
#pragma unroll
            for (int j = 0; j < 4; ++j) { const f32x4 o = xv[j] * s2 * gq[j]; u32x2 w; w.x = pg8::cvt_pk_bf16(o[0], o[1]); w.y = pg8::cvt_pk_bf16(o[2], o[3]);
                *(u32x2*)(aout + (size_t)m * D + 4 * lane + 256 * j) = w; }
        }
    }
}

__device__ __forceinline__ int srccol(int mode, int n) {
    if (mode == 1) { const int t = n >> 8, r = n & 255; return r < 128 ? t * 128 + r : 1024 + t * 128 + (r - 128); }
    if (mode == 2) { if (n < 1024) return n; const int q = n - 1024, t = q >> 8, r = q & 255; return r < 128 ? 1024 + t * 128 + r : 2048 + t * 128 + (r - 128); }
    return n;
}
__device__ __forceinline__ unsigned f2bf(float f) { unsigned u = __float_as_uint(f); return (u + 0x7fffu + ((u >> 16) & 1u)) >> 16; }
__device__ __forceinline__ unsigned pk2(float lo, float hi) { return f2bf(lo) | (f2bf(hi) << 16); }
template <bool HAS_G> __device__ __forceinline__ void transpose_item(const float* W, int K, int N, bf16_t* WT, int mode, const float* gk, LAS float* scr, int item, int lane) {
    const int nblk = N / 32, kb = item / nblk, nb = item % nblk, k0 = 64 * kb, n0 = 32 * nb, s0 = srccol(mode, n0);
#pragma unroll 8
    for (int i = 0; i < 32; ++i) { const int kk = 2 * i + (lane >> 5); scr[kk * 33 + (lane & 31)] = W[(size_t)(k0 + kk) * N + s0 + (lane & 31)] * (HAS_G ? gk[k0 + kk] : 1.0f); }
    asm volatile("s_waitcnt lgkmcnt(0)" ::: "memory");
    const int c = lane & 7;
#pragma unroll
    for (int j = 0; j < 4; ++j) { const int n = (lane >> 3) + 8 * j; const LAS float* s = scr + (8 * c) * 33 + n;
        u32x4 o; o.x = pk2(s[0 * 33], s[1 * 33]); o.y = pk2(s[2 * 33], s[3 * 33]); o.z = pk2(s[4 * 33], s[5 * 33]); o.w = pk2(s[6 * 33], s[7 * 33]);
        *(u32x4*)(WT + (size_t)(n0 + n) * K + k0 + 8 * c) = o; }
    asm volatile("s_waitcnt lgkmcnt(0)" ::: "memory");
}
template <bool HAS_G> __device__ __forceinline__ void convert_w(const float* W, int K, int N, bf16_t* WT, int mode, const float* gk, LAS float* scr, int gw, int NGW, int lane) {
    const int nitems = (K / 64) * (N / 32);
    for (int it = gw; it < nitems; it += NGW) transpose_item<HAS_G>(W, K, N, WT, mode, gk, scr, it, lane);
}

__device__ __forceinline__ void rot_phase(const int* pos, unsigned* ROT, int rows, int gtid, int NT) {
    for (int idx = gtid; idx < rows * 128; idx += NT) {
        const int m = idx >> 7, f = idx & 127;
        double w = 1.0, b = 0.9305720409296989; int e = f;
#pragma unroll
        for (int k = 0; k < 7; ++k) { if (e & 1) w *= b; b *= b; e >>= 1; }
        const double ang = (double)pos[m] * w;
        const double kq = __builtin_rint(ang * 0.6366197723675814);
        double r = __builtin_fma(-kq, 1.5707963267948966, ang); r = __builtin_fma(-kq, 6.123233995736766e-17, r);
        const int q = (int)((long long)kq & 3);
        const double r2 = r * r;
        const double sp = r * (1.0 + r2 * (-1.0 / 6 + r2 * (1.0 / 120 + r2 * (-1.0 / 5040 + r2 * (1.0 / 362880 + r2 * (-1.0 / 39916800))))));
        const double cp = 1.0 + r2 * (-0.5 + r2 * (1.0 / 24 + r2 * (-1.0 / 720 + r2 * (1.0 / 40320 + r2 * (-1.0 / 3628800 + r2 * (1.0 / 479001600))))));
        const double c = (q == 0) ? cp : (q == 1) ? -sp : (q == 2) ? -cp : sp;
        const double s = (q == 0) ? sp : (q == 1) ? cp : (q == 2) ? -sp : -cp;
        ROT[idx] = pg8::cvt_pk_bf16((float)c, (float)s);
    }
}

__device__ __forceinline__ void scan_phase(bf16_t* BC, int nseq, int G, int bid, int tid) {
    for (int it = bid * 512 + tid; it < nseq * 4 * 512 * 32; it += G * 512) {
        const int dk8 = it & 31, dv = (it >> 5) & 511, h = (it >> 14) & 3, bl = it >> 16;
        bf16_t* p = BC + ((size_t)((bl * 16) * 4 + h) * 512 + dv) * 512 + 256 + dk8 * 8;
        const size_t cs = (size_t)4 * 512 * 512;
        u32x4 kv[15];
#pragma unroll
        for (int c = 0; c < 15; ++c) kv[c] = *(const u32x4*)(p + c * cs);
        const float g256 = __builtin_amdgcn_exp2f(256.0f * l2gamma(h));
        float s[8];
#pragma unroll
        for (int k = 0; k < 8; ++k) s[k] = 0.f;
#pragma unroll
        for (int c = 0; c < 16; ++c) {
            u32x4 w; w.x = pg8::cvt_pk_bf16(s[0], s[1]); w.y = pg8::cvt_pk_bf16(s[2], s[3]); w.z = pg8::cvt_pk_bf16(s[4], s[5]); w.w = pg8::cvt_pk_bf16(s[6], s[7]);
            *(u32x4*)(p + c * cs) = w;
            if (c < 15) { const u32x4 q = kv[c];
                s[0] = g256 * (s[0] + pg8::bf_lo(q.x)); s[1] = g256 * (s[1] + pg8::bf_hi(q.x)); s[2] = g256 * (s[2] + pg8::bf_lo(q.y)); s[3] = g256 * (s[3] + pg8::bf_hi(q.y));
                s[4] = g256 * (s[4] + pg8::bf_lo(q.z)); s[5] = g256 * (s[5] + pg8::bf_hi(q.z)); s[6] = g256 * (s[6] + pg8::bf_lo(q.w)); s[7] = g256 * (s[7] + pg8::bf_hi(q.w)); }
        }
    }
}

__device__ __forceinline__ void cf_conv_phase(const bf16_t* HG, const float* wdw, const float* bdw, const float* lng, const float* lnb, bf16_t* out, LAS float* red, int rows, int G, int bid, int tid) {
    const int lane = tid & 63, wave = tid >> 6, c0 = 2 * tid;
    f32x2 w[31];
#pragma unroll
    for (int k = 0; k < 31; ++k) w[k] = *(const f32x2*)(wdw + k * 1024 + c0);
    const f32x2 bd = *(const f32x2*)(bdw + c0), lg = *(const f32x2*)(lng + c0), lb = *(const f32x2*)(lnb + c0);
    const int nu = rows / 8;
    unsigned xr[38], xn[38];
#define CF_LOADROWS(dst, uu) do { const int t0_ = (uu) * 8, s0_ = t0_ & (SEQ - 1); _Pragma("unroll") for (int r = 0; r < 38; ++r) \
        dst[r] = (s0_ - 30 + r >= 0) ? *(const unsigned*)(HG + (size_t)(t0_ - 30 + r) * 1024 + c0) : 0u; } while (0)
    if (bid < nu) CF_LOADROWS(xr, bid);
    int itn = 0;
    for (int u = bid; u < nu; u += G, ++itn) {
        const int t0 = u * 8;
        if (u + G < nu) CF_LOADROWS(xn, u + G);
        f32x2 acc[8];
#pragma unroll
        for (int i = 0; i < 8; ++i) acc[i] = bd;
#pragma unroll
        for (int r = 0; r < 38; ++r) { const f32x2 xv = (f32x2){pg8::bf_lo(xr[r]), pg8::bf_hi(xr[r])};
#pragma unroll
            for (int i = 0; i < 8; ++i) { const int k = r - i; if (k >= 0 && k <= 30) acc[i] += w[k] * xv; } }
        float p[16];
#pragma unroll
        for (int i = 0; i < 8; ++i) { p[2 * i] = acc[i].x + acc[i].y; p[2 * i + 1] = acc[i].x * acc[i].x + acc[i].y * acc[i].y; }
#pragma unroll
        for (int i = 0; i < 16; ++i) p[i] = wave_sum_u(p[i]);
        LAS float* rb = red + (itn & 1) * 128;
        if (lane < 16) { float mine = p[0];
#pragma unroll
            for (int i = 1; i < 16; ++i) mine = (lane == i) ? p[i] : mine;
            rb[wave * 16 + lane] = mine; }
        __syncthreads();
        float tot = 0.f;
        if (lane < 16) {
#pragma unroll
            for (int wv = 0; wv < 8; ++wv) tot += rb[wv * 16 + lane]; }
#pragma unroll
        for (int i = 0; i < 8; ++i) {
            const float s1 = __int_as_float(__builtin_amdgcn_readlane(__float_as_int(tot), 2 * i)), s2 = __int_as_float(__builtin_amdgcn_readlane(__float_as_int(tot), 2 * i + 1));
            const float mean = s1 * (1.0f / 1024.0f); const float var = fmaxf(s2 * (1.0f / 1024.0f) - mean * mean, 0.f); const float rstd = __builtin_amdgcn_rsqf(var + LN_EPS);
            const float v0 = (acc[i].x - mean) * rstd * lg.x + lb.x, v1 = (acc[i].y - mean) * rstd * lg.y + lb.y;
            *(unsigned*)(out + (size_t)(t0 + i) * 1024 + c0) = pg8::cvt_pk_bf16(v0 * pg8::fast_sigmoid(v0), v1 * pg8::fast_sigmoid(v1)); }
#pragma unroll
        for (int r = 0; r < 38; ++r) xr[r] = xn[r];
    }
#undef CF_LOADROWS
    __syncthreads();
}

__device__ __forceinline__ void sc_conv_phase(const bf16_t* GB, const bf16_t* GCH, const float* wcv, bf16_t* Z, int rows, int G, int bid, int tid) {
    const int cg = (tid & 127) * 8, rsub = tid >> 7;
    float w0[8], w1[8], w2[8];
#pragma unroll
    for (int j = 0; j < 8; ++j) { w0[j] = wcv[cg + j]; w1[j] = wcv[1024 + cg + j]; w2[j] = wcv[2048 + cg + j]; }
    for (int rbase = bid * 4; rbase < rows; rbase += 2 * G * 4) {
        u32x4 q0[2], q1[2], q2[2], gq[2];
#pragma unroll
        for (int e = 0; e < 2; ++e) { const int t = rbase + e * G * 4 + rsub, s = t & (SEQ - 1); const u32x4 z4 = (u32x4){0u, 0u, 0u, 0u};
            q2[e] = *(const u32x4*)(GCH + (size_t)t * 1024 + cg);
            q1[e] = s >= 1 ? *(const u32x4*)(GCH + (size_t)(t - 1) * 1024 + cg) : z4;
            q0[e] = s >= 2 ? *(const u32x4*)(GCH + (size_t)(t - 2) * 1024 + cg) : z4;
            gq[e] = *(const u32x4*)(GB + (size_t)t * 1024 + cg); }
#pragma unroll
        for (int e = 0; e < 2; ++e) { const int t = rbase + e * G * 4 + rsub;
            const unsigned a0[4] = {q0[e].x, q0[e].y, q0[e].z, q0[e].w}, a1[4] = {q1[e].x, q1[e].y, q1[e].z, q1[e].w}, a2[4] = {q2[e].x, q2[e].y, q2[e].z, q2[e].w}, ag[4] = {gq[e].x, gq[e].y, gq[e].z, gq[e].w};
            unsigned o[4];
#pragma unroll
            for (int k = 0; k < 4; ++k) {
                const float lo = pg8::bf_lo(ag[k]) * (w0[2 * k] * pg8::bf_lo(a0[k]) + w1[2 * k] * pg8::bf_lo(a1[k]) + w2[2 * k] * pg8::bf_lo(a2[k]));
                const float hi = pg8::bf_hi(ag[k]) * (w0[2 * k + 1] * pg8::bf_hi(a0[k]) + w1[2 * k + 1] * pg8::bf_hi(a1[k]) + w2[2 * k + 1] * pg8::bf_hi(a2[k]));
                o[k] = pg8::cvt_pk_bf16(lo, hi); }
            *(u32x4*)(Z + (size_t)t * 1024 + cg) = (u32x4){o[0], o[1], o[2], o[3]}; }
    }
}

struct Args { const float* in[19]; float* out; unsigned char* ws; int ph_lo, ph_hi; };
constexpr int NPHASES = 1 + 8 + 6 + 6 + 9;
static_assert(NTEAM == 1, "the two weight buffers alternate between layers: one team");

__device__ __forceinline__ void convert_layer(const Args& args, int L, unsigned char* wb, LAS float* scr, int gw, int NGW, int lane) {
    bf16_t* WM1 = (bf16_t*)wb; bf16_t* WM2 = (bf16_t*)(wb + 12 * MiB); bf16_t* W1 = (bf16_t*)(wb + 16 * MiB); bf16_t* W2 = (bf16_t*)(wb + 24 * MiB);
    const int kind = L % 3, j = L / 3; const float* g0 = args.in[2] + (size_t)(L * 4 + 0) * D; const float* g2 = args.in[2] + (size_t)(L * 4 + 2) * D;
    if (kind == 0) { convert_w<true>(args.in[3] + (size_t)j * D * RIN, D, RIN, WM1, 0, g0, scr, gw, NGW, lane); convert_w<false>(args.in[5] + (size_t)j * VD * D, VD, D, WM2, 0, nullptr, scr, gw, NGW, lane); }
    else if (kind == 1) { convert_w<true>(args.in[6], D, 2 * D, WM1, 1, g0, scr, gw, NGW, lane); convert_w<false>(args.in[12], D, D, WM2, 0, nullptr, scr, gw, NGW, lane); }
    else { convert_w<true>(args.in[14], D, 3 * D, WM1, 2, g0, scr, gw, NGW, lane); convert_w<false>(args.in[16], D, D, WM2, 0, nullptr, scr, gw, NGW, lane); }
    convert_w<true>(args.in[17] + (size_t)L * D * FF, D, FF, W1, 0, g2, scr, gw, NGW, lane);
    convert_w<false>(args.in[18] + (size_t)L * FF * D, FF, D, W2, 0, nullptr, scr, gw, NGW, lane);
}
__device__ __forceinline__ void pre_norm0(const float* x, bf16_t* xb, float* ssq2, int rows, int gw, int NGW, int lane) {
    for (int m0 = gw; m0 < rows; m0 += 2 * NGW) {
        f32x4 v[2][4];
#pragma unroll
        for (int r = 0; r < 2; ++r)
#pragma unroll
            for (int j = 0; j < 4; ++j) v[r][j] = *(const f32x4*)(x + (size_t)(m0 + r * NGW) * D + 4 * lane + 256 * j);
#pragma unroll
        for (int r = 0; r < 2; ++r) { const size_t m = (size_t)(m0 + r * NGW); float ss = 0.f;
#pragma unroll
            for (int j = 0; j < 4; ++j) {
                u32x2 w; w.x = pg8::cvt_pk_bf16(v[r][j][0], v[r][j][1]); w.y = pg8::cvt_pk_bf16(v[r][j][2], v[r][j][3]); *(u32x2*)(xb + m * D + 4 * lane + 256 * j) = w;
                const f32x4 q = (f32x4){pg8::bf_lo(w.x), pg8::bf_hi(w.x), pg8::bf_lo(w.y), pg8::bf_hi(w.y)};
                ss += (q[0] * q[0] + q[1] * q[1]) + (q[2] * q[2] + q[3] * q[3]); }
            ss = wave_sum_u(ss);
            if (lane == 0) *(f32x4*)(ssq2 + m * 4) = (f32x4){ss, 0.f, 0.f, 0.f}; }
    }
}

__global__ void __launch_bounds__(NWAVES * 64, 2) trunk_fwd(Args args) {
    extern __shared__ __attribute__((aligned(16))) unsigned char lds_raw[];
    LAS unsigned char* lds = (LAS unsigned char*)lds_raw;
    volatile LAS unsigned* MISC = (volatile LAS unsigned*)(lds + MISC_OFF);
    const int tid0 = threadIdx.x;
    const int wave0 = __builtin_amdgcn_readfirstlane(tid0 >> 6);
    const int team = (NTEAM == 2) ? ((blockIdx.x >> 3) & 1) : 0, bid = (NTEAM == 2) ? ((blockIdx.x & 7) | ((blockIdx.x >> 4) << 3)) : (int)blockIdx.x, G = gridDim.x / NTEAM;
    const int NGW = G * NWAVES;
    unsigned char* ws = args.ws;
    for (int u = tid0; u < (LDS_BYTES - LDSCTL_OFF) / 4; u += NWAVES * 64) ((LAS unsigned*)(lds + LDSCTL_OFF))[u] = 0u;
    __syncthreads();
    XcdBarrier bar = xcd_barrier_post((unsigned*)(ws + WS_CTL) + CW_BAR + team * XCD_BAR_WORDS, MISC + 8, (unsigned)G);
    const int lo = args.ph_lo, hi = args.ph_hi;
    int ph = 0;
#define PH_BEGIN if (ph >= lo && ph < hi) { int tid; asm volatile("v_mbcnt_lo_u32_b32 %0, -1, 0\n\tv_mbcnt_hi_u32_b32 %0, -1, %0" : "=v"(tid)); tid += wave0 * 64; const int lane = tid & 63, wave = __builtin_amdgcn_readfirstlane(tid >> 6), gw = bid * NWAVES + wave; LAS float* scr = (LAS float*)(lds + wave * 16384); (void)lane; (void)gw; (void)scr;
#define PH_END } if (ph >= lo && ph + 1 < hi) { xcd_barrier(bar); } ++ph;

    const size_t rb = (size_t)team * MT;
    const float* x_in = args.in[0] + rb * D; const int* positions = (const int*)args.in[1] + rb; const float* norm_g = args.in[2];
    float* outp = args.out + rb * D;
    bf16_t* xb = (bf16_t*)(ws + WS_XB) + rb * D;
    unsigned* ROT = (unsigned*)(ws + WS_ROT) + rb * 128; f32x2* GST = (f32x2*)(ws + WS_GST) + rb * 8;
    float* SSQ = (float*)(ws + WS_SQ) + rb * 4; float* SSQ0 = (float*)(ws + WS_SQ0) + rb * 4; unsigned long long* XS = (unsigned long long*)(ws + WS_XS) + rb * 4;
    unsigned* ctl = (unsigned*)(ws + WS_CTL);
    unsigned char* R = ws + WS_R;

    PH_BEGIN
        convert_layer(args, 0, ws + WS_W, scr, gw, NGW, lane);
        rot_phase(positions, ROT, MT, bid * 512 + tid, G * 512);
        pre_norm0(x_in, xb, SSQ, MT, gw, NGW, lane);
    PH_END

    for (int L = 0; L < DEPTH; ++L) {
        const int kind = L % 3, jl = L / 3;
        const float* g_post1 = norm_g + (size_t)(L * 4 + 1) * D;
        unsigned char* wb = ws + WS_W;
        if (L > 0) {
            PH_BEGIN
                convert_layer(args, L, wb, scr, gw, NGW, lane);
            PH_END
        }
        bf16_t* WM1 = (bf16_t*)wb; bf16_t* WM2 = (bf16_t*)(wb + 12 * MiB); bf16_t* W1 = (bf16_t*)(wb + 16 * MiB); bf16_t* W2 = (bf16_t*)(wb + 24 * MiB);
        if (kind == 0) {
            const float* gng = args.in[4] + (size_t)jl * VD;
            bf16_t* BC = (bf16_t*)R; bf16_t* QP = (bf16_t*)args.out; bf16_t* KK = (bf16_t*)(R + 256 * MiB); bf16_t* KT = (bf16_t*)(R + 320 * MiB); bf16_t* OH = (bf16_t*)(R + 256 * MiB);
            { const int grp = 0;
                const bf16_t* ah = xb + (size_t)grp * MQ * D;
                const unsigned* roth = ROT + (size_t)grp * MQ * 128;
                f32x2* gsth = GST + (size_t)grp * MQ * 8;
                const float* ssqh = SSQ + (size_t)grp * MQ * 4;
                PH_BEGIN
                    { SchedP1 S; S.o0.init(PQ, 8, G, bid); S.o1.init(8, PQ, G, bid); S.n0 = (PQ * 8) / G; S.X = (const char*)ah; S.W = (const char*)WM1;
                      EpiP1 E{EpiRetN{QP, KK, KT, roth, ssqh, (LAS bf16_t*)(lds + LDSCTL_OFF + 2048)}, EpiRetT{BC}};
                      pg8::gemm_phase<EpiP1, SchedP1, true, true>(lds, tid, D, D, D, S, E); }
                PH_END
                PH_BEGIN
                    { SchedR1 S; S.init(PQ, 4, G, bid); S.QP = (const char*)QP; S.KK = (const char*)KK;
                      EpiS E{QP}; pg8::gemm_phase<EpiS, SchedR1, true, true>(lds, tid, 2048, 1024, 256, S, E); }
                    { SchedR2 S; S.init(PQ, 8, G, bid); S.BC = (const char*)BC; S.KT = (const char*)KT;
                      EpiKV E{BC}; pg8::gemm_phase<EpiKV, SchedR2, true, true>(lds, tid, 512, MQ, 256, S, E); }
                PH_END
                PH_BEGIN
                    scan_phase(BC, MQ / SEQ, G, bid, tid);
                PH_END
                PH_BEGIN
                    { SchedR4 S; S.init(PQ, 8, G, bid); S.QP = (const char*)QP; S.BC = (const char*)BC;
                      EpiO E{OH, gsth, (LAS f32x2*)(lds + LDSCTL_OFF + 2048)}; pg8::gemm_phase<EpiO, SchedR4, true, true>(lds, tid, 2048, 512, 512, S, E); }
                PH_END
                PH_BEGIN
                    { SchedStd S; S.init(PQ, 8, G, bid); S.A = (const char*)ah; S.sa = (size_t)256 * D * 2; S.B = (const char*)(WM1 + (size_t)4096 * D); S.sb = (size_t)256 * D * 2;
                      EpiG E{OH, gsth, gng, ssqh}; pg8::gemm_phase<EpiG, SchedStd, true, true>(lds, tid, D, D, D, S, E); }
                PH_END
                PH_BEGIN
                    { SchedRnd S; S.init(PQ, G, bid); S.A = (const char*)OH; S.sa = (size_t)256 * VD * 2; S.B = (const char*)WM2; S.sb = (size_t)256 * VD * 2;
                      EpiNorm E{xb + (size_t)grp * MQ * D, xb + (size_t)grp * MQ * D, nullptr, SSQ0 + (size_t)grp * MQ * 4, g_post1, nullptr,
                                XS + (size_t)grp * MQ * 4, (unsigned)(2 * L + 1), ctl + CW_TMO, nullptr, lds + LDSCTL_OFF + 2048};
                      pg8::gemm_phase<EpiNorm, SchedRnd, true, true>(lds, tid, VD, VD, VD, S, E); }
                PH_END
            }
        } else if (kind == 1) {
            bf16_t* HG = (bf16_t*)R; bf16_t* ACF = (bf16_t*)(R + 64 * MiB);
            PH_BEGIN
                { SchedStd S; S.init(PT, 8, G, bid); S.A = (const char*)xb; S.sa = (size_t)256 * D * 2; S.B = (const char*)WM1; S.sb = (size_t)256 * D * 2;
                  EpiGLU E{HG, args.in[7], SSQ}; pg8::gemm_phase<EpiGLU, SchedStd, true, true>(lds, tid, D, D, D, S, E); }
            PH_END
            PH_BEGIN
                cf_conv_phase(HG, args.in[8], args.in[9], args.in[10], args.in[11], ACF, (LAS float*)lds, MT, G, bid, tid);
            PH_END
            PH_BEGIN
                { SchedRnd S; S.init(PT, G, bid); S.A = (const char*)ACF; S.sa = (size_t)256 * D * 2; S.B = (const char*)WM2; S.sb = (size_t)256 * D * 2;
                  EpiNorm E{xb, xb, nullptr, SSQ0, g_post1, args.in[13], XS, (unsigned)(2 * L + 1), ctl + CW_TMO, nullptr, lds + LDSCTL_OFF + 2048};
                  pg8::gemm_phase<EpiNorm, SchedRnd, true, true>(lds, tid, D, D, D, S, E); }
            PH_END
        } else {
            bf16_t* GB = (bf16_t*)R; bf16_t* GCH = (bf16_t*)(R + 64 * MiB); bf16_t* Z = (bf16_t*)(R + 128 * MiB);
            PH_BEGIN
                { SchedStd S; S.init(PT, 12, G, bid); S.A = (const char*)xb; S.sa = (size_t)256 * D * 2; S.B = (const char*)WM1; S.sb = (size_t)256 * D * 2;
                  EpiSC E{GB, GCH, SSQ}; pg8::gemm_phase<EpiSC, SchedStd, true, true>(lds, tid, D, D, D, S, E); }
            PH_END
            PH_BEGIN
                sc_conv_phase(GB, GCH, args.in[15], Z, MT, G, bid, tid);
            PH_END
            PH_BEGIN
                { SchedRnd S; S.init(PT, G, bid); S.A = (const char*)Z; S.sa = (size_t)256 * D * 2; S.B = (const char*)WM2; S.sb = (size_t)256 * D * 2;
                  EpiNorm E{xb, xb, nullptr, SSQ0, g_post1, nullptr, XS, (unsigned)(2 * L + 1), ctl + CW_TMO, nullptr, lds + LDSCTL_OFF + 2048};
                  pg8::gemm_phase<EpiNorm, SchedRnd, true, true>(lds, tid, D, D, D, S, E); }
            PH_END
        }
        bf16_t* H = (bf16_t*)R;
        PH_BEGIN
            { SchedStd S; S.init(PT, 16, G, bid); S.A = (const char*)xb; S.sa = (size_t)256 * D * 2; S.B = (const char*)W1; S.sb = (size_t)256 * D * 2;
              EpiRelu2 E{H, FF}; pg8::gemm_phase<EpiRelu2, SchedStd, true, true>(lds, tid, D, D, D, S, E); }
        PH_END
        PH_BEGIN
            const bool fin = (L + 1 == DEPTH);
            { SchedRnd S; S.init(PT, G, bid); S.A = (const char*)H; S.sa = (size_t)256 * FF * 2; S.B = (const char*)W2; S.sb = (size_t)256 * FF * 2;
              EpiNorm E{xb, xb, fin ? outp : nullptr, SSQ, norm_g + (size_t)(L * 4 + 3) * D, nullptr, XS, (unsigned)(2 * L + 2), ctl + CW_TMO, SSQ0, lds + LDSCTL_OFF + 2048};
              pg8::gemm_phase<EpiNorm, SchedRnd, true, true>(lds, tid, FF, FF, FF, S, E); }
        PH_END
    }
#undef PH_BEGIN
#undef PH_END
}

extern "C" void kernel_launch(void* const* d_in, const int* in_sizes, int n_in, void* d_out, int out_size, void* d_ws, size_t ws_size, hipStream_t stream) {
    static int grid = 0;
    if (grid == 0) {
        if (n_in != 19 || out_size != M * D || ws_size < WS_END) { fprintf(stderr, "kernel_launch: unexpected problem shape (n_in %d, out %d, ws %zu)\n", n_in, out_size, ws_size); grid = -1; return; }
        int dev = 0, cus = 0, per_cu = 0;
        if (hipGetDevice(&dev) != hipSuccess || hipDeviceGetAttribute(&cus, hipDeviceAttributeMultiprocessorCount, dev) != hipSuccess) { grid = -1; return; }
        if (hipFuncSetAttribute((const void*)trunk_fwd, hipFuncAttributeMaxDynamicSharedMemorySize, LDS_BYTES) != hipSuccess) { fprintf(stderr, "kernel_launch: hipFuncSetAttribute failed\n"); grid = -1; return; }
        if (hipOccupancyMaxActiveBlocksPerMultiprocessor(&per_cu, (const void*)trunk_fwd, NWAVES * 64, LDS_BYTES) != hipSuccess || per_cu < 1)
            fprintf(stderr, "kernel_launch: occupancy query reports %d workgroups per CU\n", per_cu);
        (void)hipGetLastError();
        if (cus < 256) { fprintf(stderr, "kernel_launch: built for a 256-CU device (got %d)\n", cus); grid = -1; return; }
        grid = 256;
    }
    if (grid < 0) return;
    if (hipMemsetAsync((char*)d_ws + WS_CTL, 0, CTL_ZERO_BYTES, stream) != hipSuccess) return;
    Args a{};
    for (int i = 0; i < 19; ++i) a.in[i] = (const float*)d_in[i];
    a.out = (float*)d_out; a.ws = (unsigned char*)d_ws;
#if MK_PER_PHASE
    for (int p = 0; p < NPHASES; ++p) { a.ph_lo = p; a.ph_hi = p + 1; hipLaunchKernelGGL(trunk_fwd, dim3(grid), dim3(NWAVES * 64), LDS_BYTES, stream, a); }
#else
    a.ph_lo = 0; a.ph_hi = NPHASES;
    hipLaunchKernelGGL(trunk_fwd, dim3(grid), dim3(NWAVES * 64), LDS_BYTES, stream, a);
#endif
}
```
